# Optimizing an MI355X kernel written in HIP

```python
import math
import jax, jax.numpy as jnp
from jax import lax
import numpy as np

D_MODEL = 1024
BATCH = 32
SEQ = 256
DEPTH = 4
DEC_BATCH = 8
DEC_SEQ = 1024
PAST_LEN = 512

F32 = jnp.float32
GRID_W = 64
N_EVEN = (DEPTH + 1) // 2
N_ODD = DEPTH // 2
HEAD_DIM = 64
ROPE_BASE = 10000.0
Q_BLOCK = 128
MASK_VALUE = -1e30
F_FLOOR = 1e-30
A_HEADS = 8
A_KV = 2
WINDOW = 128
B_HEADS = 4
B_DK = 128
B_DV = 128
B_CHUNK = 16
C_HEADS = 8
C_Q_LORA = 384
C_KV_LORA = 256
C_NOPE = 64
C_ROPE = 32
C_V = 64
D_HEADS = 8
D_KV = 4
MIX = A_HEADS * HEAD_DIM + B_HEADS * B_DV
D_FF = -(-8 * D_MODEL // (3 * 256)) * 256
EVEN_SIZES = (A_HEADS * HEAD_DIM, A_KV * HEAD_DIM, A_KV * HEAD_DIM,
              B_HEADS * B_DK, B_HEADS * B_DV, B_HEADS * B_DK, B_HEADS * B_DK, B_HEADS * B_DV)
ODD_SIZES = (C_Q_LORA, C_KV_LORA, C_ROPE, D_HEADS * HEAD_DIM, D_KV * HEAD_DIM, D_KV * HEAD_DIM)
EVEN_SPLIT = tuple(int(i) for i in np.cumsum(EVEN_SIZES)[:-1])
ODD_SPLIT = tuple(int(i) for i in np.cumsum(ODD_SIZES)[:-1])
EVEN_IN = int(sum(EVEN_SIZES))
ODD_IN = int(sum(ODD_SIZES))
ALPHA = (2 * DEPTH) ** 0.25
BETA = (8 * DEPTH) ** -0.25

kernel_name = 'hybrid_flow_backbone_step'


def rms_norm(x, g, eps=1e-6):
    xf = x.astype(F32)
    y = xf * lax.rsqrt(jnp.mean(xf * xf, axis=-1, keepdims=True) + eps)
    return (y * g.astype(F32)).astype(x.dtype)


def layer_norm(x, g, b, eps=1e-5):
    xf = x.astype(F32)
    mu = jnp.mean(xf, axis=-1, keepdims=True)
    xc = xf - mu
    var = jnp.mean(xc * xc, axis=-1, keepdims=True)
    return (xc * lax.rsqrt(var + eps) * g.astype(F32) + b.astype(F32)).astype(x.dtype)


def axial_rope_tables(n_tokens, rot_dim):
    n_rows = n_tokens // GRID_W
    row = jnp.broadcast_to(jnp.arange(n_rows, dtype=F32)[:, None], (n_rows, GRID_W)).reshape(-1)
    col = jnp.broadcast_to(jnp.arange(GRID_W, dtype=F32)[None, :], (n_rows, GRID_W)).reshape(-1)
    quarter = rot_dim // 4
    inv = ROPE_BASE ** (-jnp.arange(quarter, dtype=F32) / quarter)
    ar = row[:, None] * inv
    ac = col[:, None] * inv
    return (jnp.cos(ar), jnp.sin(ar), jnp.cos(ac), jnp.sin(ac))


def apply_axial_rope(x, tables):
    cos_r, sin_r, cos_c, sin_c = tables
    half = x.shape[-1] // 2
    xf = x.astype(F32)

    def rot(t, cos, sin):
        t1, t2 = jnp.split(t, 2, axis=-1)
        cos = cos[:, None, :]
        sin = sin[:, None, :]
        return jnp.concatenate([t1 * cos - t2 * sin, t2 * cos + t1 * sin], axis=-1)

    out = jnp.concatenate([rot(xf[..., :half], cos_r, sin_r), rot(xf[..., half:], cos_c, sin_c)], axis=-1)
    return out.astype(x.dtype)


def dense_gqa(q, k, v, sink=None):
    b, lq, h, dq = q.shape
    kv = k.shape[2]
    g = h // kv
    dv = v.shape[-1]
    scale = dq ** -0.5
    qb = q.reshape(b, lq // Q_BLOCK, Q_BLOCK, kv, g, dq).transpose(1, 0, 2, 3, 4, 5)

    def one_block(qblk):
        s = jnp.einsum('bqkgd,bskd->bkgqs', qblk, k).astype(F32) * scale
        if sink is not None:
            sk = jnp.broadcast_to(sink.astype(F32).reshape(1, kv, g, 1, 1), s.shape[:-1] + (1,))
            p = jax.nn.softmax(jnp.concatenate([s, sk], axis=-1), axis=-1)[..., :-1]
        else:
            p = jax.nn.softmax(s, axis=-1)
        return jnp.einsum('bkgqs,bskd->bqkgd', p.astype(v.dtype), v)

    o = lax.map(one_block, qb)
    return o.transpose(1, 0, 2, 3, 4, 5).reshape(b, lq, h, dv)


def banded_gqa_with_context(q, k, v, k_ctx, v_ctx, sink):
    b, l, h, d = q.shape
    kv = k.shape[2]
    g = h // kv
    nb = l // Q_BLOCK
    p_len = k_ctx.shape[1]
    scale = d ** -0.5
    qb = q.reshape(b, nb, Q_BLOCK, kv, g, d)

    def windows(t):
        tp = jnp.pad(t, ((0, 0), (Q_BLOCK, Q_BLOCK), (0, 0), (0, 0))).reshape(b, nb + 2, Q_BLOCK, kv, d)
        return jnp.concatenate([tp[:, :-2], tp[:, 1:-1], tp[:, 2:]], axis=2)

    kw, vw = windows(k), windows(v)
    qpos = jnp.arange(l).reshape(nb, Q_BLOCK)
    kpos = (jnp.arange(nb)[:, None] - 1) * Q_BLOCK + jnp.arange(3 * Q_BLOCK)[None, :]
    kp = kpos[:, None, :]
    valid = (kp >= 0) & (kp < l) & (jnp.abs(kp - qpos[:, :, None]) <= WINDOW)
    s_loc = jnp.einsum('bnqkgd,bnskd->bkgnqs', qb, kw).astype(F32) * scale
    s_loc = jnp.where(valid, s_loc, MASK_VALUE)
    s_ctx = jnp.einsum('bnqkgd,bpkd->bkgnqp', qb, k_ctx).astype(F32) * scale
    sk = jnp.broadcast_to(sink.astype(F32).reshape(1, kv, g, 1, 1, 1), s_loc.shape[:-1] + (1,))
    p = jax.nn.softmax(jnp.concatenate([s_loc, s_ctx, sk], axis=-1), axis=-1)
    p_loc = p[..., :3 * Q_BLOCK].astype(v.dtype)
    p_ctx = p[..., 3 * Q_BLOCK:3 * Q_BLOCK + p_len].astype(v.dtype)
    o = jnp.einsum('bkgnqs,bnskd->bnqkgd', p_loc, vw) + jnp.einsum('bkgnqp,bpkd->bnqkgd', p_ctx, v_ctx)
    return o.reshape(b, l, h, d)


def hgrn2_gate(z, lb):
    f = lb + (1.0 - lb) * jax.nn.sigmoid(z.astype(F32))
    return jnp.log(jnp.maximum(f, F_FLOOR)), 1.0 - f


def hgrn2_scan(q, k, v, logf, s0):
    b, l, h, dk = q.shape
    dv = v.shape[-1]
    n = l // B_CHUNK

    def chunks(t):
        return t.astype(F32).reshape(b, n, B_CHUNK, h, t.shape[-1]).transpose(0, 3, 1, 2, 4)

    qc, kc, vc, gc = chunks(q) * dk ** -0.5, chunks(k), chunks(v), chunks(logf)
    cum = jnp.cumsum(gc, axis=3)
    tri = jnp.tril(jnp.ones((B_CHUNK, B_CHUNK), bool))[:, :, None]
    diff = cum[..., :, None, :] - cum[..., None, :, :]
    decay = jnp.where(tri, jnp.exp(jnp.where(tri, diff, 0.0)), 0.0)
    attn = jnp.einsum('bhntk,bhntsk,bhnsk->bhnts', qc, decay, kc)
    o_intra = jnp.einsum('bhnts,bhnsv->bhntv', attn, vc)
    last = cum[..., -1:, :]
    upd = jnp.einsum('bhnsk,bhnsv->bhnkv', kc * jnp.exp(last - cum), vc)
    dec = jnp.exp(last[..., 0, :])

    def step(s, inp):
        d_n, u_n = inp
        return d_n[..., None] * s + u_n, s

    s_fin, s_start = lax.scan(step, s0.astype(F32), (dec.transpose(2, 0, 1, 3), upd.transpose(2, 0, 1, 3, 4)))
    s_start = s_start.transpose(1, 2, 0, 3, 4)
    o_inter = jnp.einsum('bhntk,bhnkv->bhntv', qc * jnp.exp(cum), s_start)
    o = (o_intra + o_inter).transpose(0, 2, 3, 1, 4).reshape(b, l, h, dv)
    return o.astype(v.dtype), s_fin


def hgrn2_bidir(q, k_f, logf_f, k_b, logf_b, v, s0_f, s0_b):
    o_f, s_f = hgrn2_scan(q, k_f, v, logf_f, s0_f)
    flip = lambda t: jnp.flip(t, axis=1)
    o_b, s_b = hgrn2_scan(flip(q), flip(k_b), flip(v), flip(logf_b), s0_b)
    return o_f + flip(o_b), s_f, s_b


def mixer_ab(h, w_in, w_out, sink, lb, gnorm, rope=None, ctx=None):
    bsz, l, _ = h.shape
    qa, ka, va, qb, ib, ff, fb, gb = jnp.split(h @ w_in, EVEN_SPLIT, axis=-1)
    qa = qa.reshape(bsz, l, A_HEADS, HEAD_DIM)
    ka = ka.reshape(bsz, l, A_KV, HEAD_DIM)
    va = va.reshape(bsz, l, A_KV, HEAD_DIM)
    qb = jax.nn.silu(qb).reshape(bsz, l, B_HEADS, B_DK)
    ib = ib.reshape(bsz, l, B_HEADS, B_DV)
    logf_f, kf = hgrn2_gate(ff, lb[0])
    logf_b, kb = hgrn2_gate(fb, lb[1])
    hs = (bsz, l, B_HEADS, B_DK)
    logf_f, kf, logf_b, kb = logf_f.reshape(hs), kf.reshape(hs), logf_b.reshape(hs), kb.reshape(hs)
    if ctx is None:
        oa = dense_gqa(qa, ka, va, sink)
        zeros = jnp.zeros((bsz, B_HEADS, B_DK, B_DV), F32)
        ob, s_f, s_b = hgrn2_bidir(qb, kf, logf_f, kb, logf_b, ib, zeros, zeros)
        new = (ka, va, jnp.stack([s_f, s_b], axis=1))
    else:
        k_ctx, v_ctx, s_ctx = ctx
        oa = banded_gqa_with_context(apply_axial_rope(qa, rope), apply_axial_rope(ka, rope), va, k_ctx, v_ctx, sink)
        ob, _, _ = hgrn2_bidir(qb, kf, logf_f, kb, logf_b, ib, s_ctx[:, 0], s_ctx[:, 1])
        new = None
    ob = rms_norm(ob, gnorm) * jax.nn.silu(gb.reshape(bsz, l, B_HEADS, B_DV))
    y = jnp.concatenate([oa.reshape(bsz, l, -1), ob.reshape(bsz, l, -1)], axis=-1) @ w_out
    return y, new


def mixer_cd(h, w_in, w_out, g_cq, g_ckv, w_q_up, w_kv_up, g_dq, g_dk, rope_c=None, rope_d=None, ctx=None):
    bsz, l, _ = h.shape
    cq, ckv, kpe, qd, kd, vd = jnp.split(h @ w_in, ODD_SPLIT, axis=-1)
    qc = (rms_norm(cq, g_cq) @ w_q_up).reshape(bsz, l, C_HEADS, C_NOPE + C_ROPE)
    ckv = rms_norm(ckv, g_ckv)
    kpe = kpe[:, :, None, :]
    qd = rms_norm(qd.reshape(bsz, l, D_HEADS, HEAD_DIM), g_dq)
    kd = rms_norm(kd.reshape(bsz, l, D_KV, HEAD_DIM), g_dk)
    vd = vd.reshape(bsz, l, D_KV, HEAD_DIM)

    def mla_kv(lat, pe):
        n = lat.shape[1]
        kvu = (lat @ w_kv_up).reshape(bsz, n, C_HEADS, C_NOPE + C_V)
        k = jnp.concatenate([kvu[..., :C_NOPE], jnp.broadcast_to(pe, (bsz, n, C_HEADS, C_ROPE))], axis=-1)
        return k, kvu[..., C_NOPE:]

    if ctx is None:
        kc, vc = mla_kv(ckv, kpe)
        oc = dense_gqa(qc, kc, vc)
        od = dense_gqa(qd, kd, vd)
        new = (ckv, kpe[:, :, 0], kd, vd)
    else:
        c_ctx, pe_ctx, kd_ctx, vd_ctx = ctx
        qc = jnp.concatenate([qc[..., :C_NOPE], apply_axial_rope(qc[..., C_NOPE:], rope_c)], axis=-1)
        kpe = apply_axial_rope(kpe, rope_c)
        kc, vc = mla_kv(jnp.concatenate([ckv, c_ctx], axis=1), jnp.concatenate([kpe, pe_ctx[:, :, None, :]], axis=1))
        oc = dense_gqa(qc, kc, vc)
        qd, kd = apply_axial_rope(qd, rope_d), apply_axial_rope(kd, rope_d)
        od = dense_gqa(qd, jnp.concatenate([kd, kd_ctx], axis=1), jnp.concatenate([vd, vd_ctx], axis=1))
        new = None
    y = jnp.concatenate([oc.reshape(bsz, l, -1), od.reshape(bsz, l, -1)], axis=-1) @ w_out
    return y, new


def swiglu(h, w_gate, w_up, w_down):
    return (jax.nn.silu(h @ w_gate) * (h @ w_up)) @ w_down


def modulation(cond, w, b):
    return jnp.split((jax.nn.silu(cond) @ w + b)[:, None, :], 6, axis=-1)


def setup_inputs(seed: int = 0) -> dict:
    key = jax.random.key(seed)
    ks = list(jax.random.split(key, 40))

    def nrm(shape, scale=1.0):
        return jax.random.normal(ks.pop(), shape, F32) * scale

    def gain(shape):
        return 1.0 + nrm(shape, 0.02)

    d = D_MODEL
    return {
        'x_prompt': nrm((BATCH, SEQ, d)),
        'x_sample': nrm((DEC_BATCH, DEC_SEQ, d)),
        'cache_a_k': nrm((DEC_BATCH, N_EVEN, PAST_LEN, A_KV, HEAD_DIM)),
        'cache_a_v': nrm((DEC_BATCH, N_EVEN, PAST_LEN, A_KV, HEAD_DIM)),
        'state_b': nrm((DEC_BATCH, N_EVEN, 2, B_HEADS, B_DK, B_DV), 0.5),
        'cache_c_kv': nrm((DEC_BATCH, N_ODD, PAST_LEN, C_KV_LORA)),
        'cache_c_pe': nrm((DEC_BATCH, N_ODD, PAST_LEN, C_ROPE)),
        'cache_d_k': nrm((DEC_BATCH, N_ODD, PAST_LEN, D_KV, HEAD_DIM)),
        'cache_d_v': nrm((DEC_BATCH, N_ODD, PAST_LEN, D_KV, HEAD_DIM)),
        'c': nrm((DEC_BATCH, d)),
        'c_ctx': nrm((d,)),
        'w_ada': nrm((DEPTH, d, 6 * d), 0.5 * d ** -0.5),
        'b_ada': nrm((DEPTH, 6 * d), 0.02),
        'ln_g': gain((DEPTH, 2, d)),
        'ln_b': nrm((DEPTH, 2, d), 0.02),
        'w_in_ab': nrm((N_EVEN, d, EVEN_IN), d ** -0.5),
        'a_sink': nrm((N_EVEN, A_HEADS), 0.5),
        'b_lb': nrm((N_EVEN, 2, B_HEADS * B_DK), 0.5),
        'b_gnorm': gain((N_EVEN, B_DV)),
        'w_in_cd': nrm((N_ODD, d, ODD_IN), d ** -0.5),
        'c_q_norm': gain((N_ODD, C_Q_LORA)),
        'c_kv_norm': gain((N_ODD, C_KV_LORA)),
        'c_w_q_up': nrm((N_ODD, C_Q_LORA, C_HEADS * (C_NOPE + C_ROPE)), C_Q_LORA ** -0.5),
        'c_w_kv_up': nrm((N_ODD, C_KV_LORA, C_HEADS * (C_NOPE + C_V)), C_KV_LORA ** -0.5),
        'd_q_norm': gain((N_ODD, HEAD_DIM)),
        'd_k_norm': gain((N_ODD, HEAD_DIM)),
        'w_out': nrm((DEPTH, MIX, d), BETA * MIX ** -0.5),
        'w_ffn_gate': nrm((DEPTH, d, D_FF), d ** -0.5),
        'w_ffn_up': nrm((DEPTH, d, D_FF), d ** -0.5),
        'w_ffn_down': nrm((DEPTH, D_FF, d), BETA * D_FF ** -0.5),
    }


def reference(x_prompt, x_sample, cache_a_k, cache_a_v, state_b, cache_c_kv, cache_c_pe, cache_d_k, cache_d_v,
              c, c_ctx, w_ada, b_ada, ln_g, ln_b, w_in_ab, a_sink, b_lb, b_gnorm, w_in_cd, c_q_norm, c_kv_norm,
              c_w_q_up, c_w_kv_up, d_q_norm, d_k_norm, w_out, w_ffn_gate, w_ffn_up, w_ffn_down):
    n_lat = x_sample.shape[1]
    rope_hd = axial_rope_tables(n_lat, HEAD_DIM)
    rope_c = axial_rope_tables(n_lat, C_ROPE)
    lb_w = jax.nn.softmax(b_lb.astype(F32), axis=0)
    lb_all = jnp.cumsum(lb_w, axis=0) - lb_w[:1]
    xp, xs = x_prompt, x_sample
    ak, av, sb, ckv, cpe, dk, dv = [], [], [], [], [], [], []
    for l in range(DEPTH):
        mp = modulation(c_ctx[None, :], w_ada[l], b_ada[l])
        ms = modulation(c, w_ada[l], b_ada[l])
        hp = xp * (1 + mp[1]) + mp[0]
        hs = xs * (1 + ms[1]) + ms[0]
        if l % 2 == 0:
            e = l // 2
            wts = (w_in_ab[e], w_out[l], a_sink[e], lb_all[e], b_gnorm[e])
            yp, (k_new, v_new, s_new) = mixer_ab(hp, *wts)
            ys, _ = mixer_ab(hs, *wts, rope=rope_hd, ctx=(cache_a_k[:, e], cache_a_v[:, e], state_b[:, e]))
            ak.append(k_new)
            av.append(v_new)
            sb.append(s_new)
        else:
            o = l // 2
            wts = (w_in_cd[o], w_out[l], c_q_norm[o], c_kv_norm[o], c_w_q_up[o], c_w_kv_up[o], d_q_norm[o], d_k_norm[o])
            yp, (c_new, pe_new, k_new, v_new) = mixer_cd(hp, *wts)
            ys, _ = mixer_cd(hs, *wts, rope_c=rope_c, rope_d=rope_hd,
                             ctx=(cache_c_kv[:, o], cache_c_pe[:, o], cache_d_k[:, o], cache_d_v[:, o]))
            ckv.append(c_new)
            cpe.append(pe_new)
            dk.append(k_new)
            dv.append(v_new)
        xp = layer_norm(ALPHA * xp + mp[2] * yp, ln_g[l, 0], ln_b[l, 0])
        xs = layer_norm(ALPHA * xs + ms[2] * ys, ln_g[l, 0], ln_b[l, 0])
        hp = xp * (1 + mp[4]) + mp[3]
        hs = xs * (1 + ms[4]) + ms[3]
        xp = layer_norm(ALPHA * xp + mp[5] * swiglu(hp, w_ffn_gate[l], w_ffn_up[l], w_ffn_down[l]), ln_g[l, 1], ln_b[l, 1])
        xs = layer_norm(ALPHA * xs + ms[5] * swiglu(hs, w_ffn_gate[l], w_ffn_up[l], w_ffn_down[l]), ln_g[l, 1], ln_b[l, 1])
    new_cache_a_k = jnp.stack(ak, axis=1)
    new_cache_a_v = jnp.stack(av, axis=1)
    new_state_b = jnp.stack(sb, axis=1).astype(x_prompt.dtype)
    new_cache_c_kv = jnp.stack(ckv, axis=1)
    new_cache_c_pe = jnp.stack(cpe, axis=1)
    new_cache_d_k = jnp.stack(dk, axis=1)
    new_cache_d_v = jnp.stack(dv, axis=1)
    return (xp, xs, new_cache_a_k, new_cache_a_v, new_state_b, new_cache_c_kv, new_cache_c_pe, new_cache_d_k, new_cache_d_v)
```

```cpp
#include <hip/hip_runtime.h>
#include <hip/hip_cooperative_groups.h>
#include <cstdio>
namespace cg = cooperative_groups;

typedef unsigned short u16;
typedef short bf16x8 __attribute__((ext_vector_type(8)));
typedef short s16x4 __attribute__((ext_vector_type(4)));
typedef float f32x16 __attribute__((ext_vector_type(16)));
typedef float f32x4 __attribute__((ext_vector_type(4)));
typedef unsigned u32x4 __attribute__((ext_vector_type(4)));
typedef unsigned u32x2 __attribute__((ext_vector_type(2)));

#define DI __device__ __forceinline__
#define SB()
#define MFMA(a, b, c) __builtin_amdgcn_mfma_f32_32x32x16_bf16((a), (b), (c), 0, 0, 0)

constexpr int NROWS = 16384;
constexpr int NPR = 8192;
constexpr float ALPHA_F = 1.681792830507429f;
constexpr float LOG2E = 1.4426950408889634f;

constexpr size_t OUT_AK = 16777216, OUT_AV = 18874368, OUT_SB = 20971520, OUT_CKV = 29360128,
                 OUT_CPE = 33554432, OUT_DK = 34078720, OUT_DV = 38273024;

constexpr size_t SZ_WAB = 2ull * 3328 * 1024 * 2, SZ_WCD = 2ull * 1792 * 1024 * 2, SZ_WQU = 2ull * 768 * 384 * 2,
                 SZ_WKVU = 2ull * 1024 * 256 * 2, SZ_WO = 4ull * 1024 * 1024 * 2, SZ_WGU = 4ull * 5632 * 1024 * 2,
                 SZ_WD = 4ull * 1024 * 2816 * 2;
constexpr size_t O_WAB = 0, O_WCD = O_WAB + SZ_WAB, O_WQU = O_WCD + SZ_WCD, O_WKVU = O_WQU + SZ_WQU,
                 O_WO = O_WKVU + SZ_WKVU, O_WGU = O_WO + SZ_WO, O_WD = O_WGU + SZ_WGU, O_MOD = O_WD + SZ_WD;
constexpr size_t SZ_MOD = 4ull * 9 * 6144 * 4;
constexpr size_t O_CS64 = O_MOD + SZ_MOD;
constexpr size_t O_CS32 = O_CS64 + 64 * 16 * 2 * 4;
constexpr size_t O_LBT = O_CS32 + 64 * 8 * 2 * 4;
constexpr size_t O_HM = O_LBT + 2 * 2 * 512 * 4;
constexpr size_t O_R1 = O_HM + 16384ull * 1024 * 2;
constexpr size_t O_QA = O_R1, O_KA = O_QA + 16384ull * 512 * 2, O_QB = O_KA + 16384ull * 128 * 2,
                 O_IB = O_QB + 16384ull * 512 * 2, O_GB = O_IB + 16384ull * 512 * 2, O_FF = O_GB + 16384ull * 512 * 2,
                 O_FB = O_FF + 16384ull * 512 * 4, O_R1E_END = O_FB + 16384ull * 512 * 4;
constexpr size_t O_PROJ = O_R1, O_CKVN = O_PROJ + 16384ull * 1792 * 2, O_KPE = O_CKVN + 20480ull * 256 * 2,
                 O_QD = O_KPE + 16384ull * 32 * 2, O_KD = O_QD + 16384ull * 512 * 2, O_QC = O_KD + 16384ull * 256 * 2,
                 O_KN = O_QC + 16384ull * 768 * 2, O_RCQ = O_KN + 20480ull * 512 * 2, O_R1O_END = O_RCQ + 16384 * 4;
constexpr size_t O_ACT = O_R1;
constexpr size_t SZ_R1 = (O_R1O_END > O_R1E_END ? O_R1O_END : O_R1E_END) - O_R1;
constexpr size_t O_OFB = O_R1 + SZ_R1;
constexpr size_t O_VTAP = O_OFB + 2ull * 16384 * 512 * 4;
constexpr size_t O_VTAL = O_VTAP + 32ull * 2 * 64 * 256 * 2;
constexpr size_t O_KCA = O_VTAL + 2ull * 8 * 2 * 64 * 1536 * 2;
constexpr size_t O_VTDP = O_KCA + 2ull * 8 * 512 * 128 * 2;
constexpr size_t O_VTDL = O_VTDP + 32ull * 4 * 64 * 256 * 2;
constexpr size_t O_KCD = O_VTDL + 2ull * 8 * 4 * 64 * 1536 * 2;
constexpr size_t O_VTCP = O_KCD + 2ull * 8 * 512 * 256 * 2;
constexpr size_t O_VTCL = O_VTCP + 32ull * 8 * 64 * 256 * 2;
constexpr size_t O_PECTX = O_VTCL + 8ull * 8 * 64 * 1536 * 2;
constexpr size_t WS_TOTAL = O_PECTX + 2ull * 8 * 512 * 32 * 2;
constexpr size_t O_BAR = (WS_TOTAL + 255) & ~(size_t)255;
constexpr size_t O_ST = O_BAR + 16384;
static_assert(O_ST + 16384 * 8 < 411000000ull, "workspace too large");
static_assert(16384ull * 2816 * 2 <= SZ_R1, "ACT must fit R1");

struct P {
  const float *x_prompt, *x_sample, *cache_a_k, *cache_a_v, *state_b, *cache_c_kv, *cache_c_pe, *cache_d_k, *cache_d_v,
      *c, *c_ctx, *w_ada, *b_ada, *ln_g, *ln_b, *w_in_ab, *a_sink, *b_lb, *b_gnorm, *w_in_cd, *c_q_norm, *c_kv_norm,
      *c_w_q_up, *c_w_kv_up, *d_q_norm, *d_k_norm, *w_out, *w_ffn_gate, *w_ffn_up, *w_ffn_down;
  float* out;
  char* ws;
};

DI float bf2f(u16 v) { return __uint_as_float(((unsigned)v) << 16); }
typedef __bf16 bf16v2 __attribute__((ext_vector_type(2)));
typedef float f32v2 __attribute__((ext_vector_type(2)));
DI unsigned pack2(float a, float b) {
  f32v2 v;
  v[0] = a;
  v[1] = b;
  return __builtin_bit_cast(unsigned, __builtin_convertvector(v, bf16v2));
}
DI u16 f2bf(float x) { return (u16)(pack2(x, x) & 0xffffu); }
DI int crow(int i, int h) { return (i & 3) + 8 * (i >> 2) + 4 * h; }
DI float silu_f(float x) { return x * __builtin_amdgcn_rcpf(1.f + __expf(-x)); }
DI float sigmoid_f(float x) { return __builtin_amdgcn_rcpf(1.f + __expf(-x)); }
DI int mod_index(int R) { return R < NPR ? 0 : 1 + ((R - NPR) >> 10); }
DI float xhalf_max(float x) {
  auto r = __builtin_amdgcn_permlane32_swap(__float_as_uint(x), __float_as_uint(x), false, false);
  return fmaxf(__uint_as_float(r[0]), __uint_as_float(r[1]));
}
DI float xhalf_sum(float x) {
  auto r = __builtin_amdgcn_permlane32_swap(__float_as_uint(x), __float_as_uint(x), false, false);
  return __uint_as_float(r[0]) + __uint_as_float(r[1]);
}
DI float wave_sum(float v) {
#pragma unroll
  for (int o = 32; o >= 1; o >>= 1) v += __shfl_xor(v, o);
  return v;
}
template <int S>
DI bf16x8 pack8(const f32x16& x) {
  u32x4 p;
  p[0] = pack2(x[8 * S + 0], x[8 * S + 1]);
  p[1] = pack2(x[8 * S + 2], x[8 * S + 3]);
  p[2] = pack2(x[8 * S + 4], x[8 * S + 5]);
  p[3] = pack2(x[8 * S + 6], x[8 * S + 7]);
  return __builtin_bit_cast(bf16x8, p);
}
DI bf16x8 cat4(s16x4 lo, s16x4 hi) { return __builtin_shufflevector(lo, hi, 0, 1, 2, 3, 4, 5, 6, 7); }
DI f32x16 zero16() {
  f32x16 z;
#pragma unroll
  for (int i = 0; i < 16; ++i) z[i] = 0.f;
  return z;
}

DI int tid_opaque() { int x = threadIdx.x; asm volatile("" : "+v"(x)); return x; }
DI int bid_opaque() { int x = blockIdx.x; asm volatile("" : "+s"(x)); return x; }
DI void st_u16(void* base, unsigned boff, u16 v) { *(u16*)((char*)base + boff) = v; }
DI void st_f32(void* base, unsigned boff, float v) { *(float*)((char*)base + boff) = v; }
#define WSP(T, off) ((T*)(p.ws + (off)))

struct TDesc { const float* g0; const float* g1; const float* kscale; u16* dst; int ld_src, kind, k0, n0, ld_dst, pad_; };

DI void transpose_load(const TDesc d, float (&v)[32]) {
  const int t = tid_opaque();
  const int n = t & 127, kh = t >> 7;
  const int nd = d.n0 + n;
  const float* src = nullptr;
  if (d.kind == 0) src = d.g0 + nd;
  else if (d.kind == 1) {
    if (nd < 640) src = d.g0 + nd;
    else if (nd < 1664) src = d.g0 + nd + 32;
    else if (nd < 1696) src = d.g0 + nd - 1024;
  } else {
    const int which = (nd >> 5) & 1, j = (nd >> 6) * 32 + (nd & 31);
    src = (which ? d.g1 : d.g0) + j;
  }
#pragma unroll
  for (int i = 0; i < 32; ++i) v[i] = src ? __builtin_nontemporal_load(src + (size_t)(d.k0 + kh + 2 * i) * d.ld_src) : 0.f;
}
DI void transpose_finish(float* sm, const TDesc d, const float (&v)[32]) {
  const int t = tid_opaque();
  {
    const int n = t & 127, kh = t >> 7;
#pragma unroll
    for (int i = 0; i < 32; ++i) {
      const int k = kh + 2 * i;
      sm[k * 129 + n] = d.kscale ? v[i] * d.kscale[d.k0 + k] : v[i];
    }
  }
  __syncthreads();
#pragma unroll
  for (int j = 0; j < 4; ++j) {
    const int c = t + 256 * j, n = c >> 3, kc = c & 7;
    u32x4 o;
#pragma unroll
    for (int q = 0; q < 4; ++q) o[q] = pack2(sm[(kc * 8 + 2 * q) * 129 + n], sm[(kc * 8 + 2 * q + 1) * 129 + n]);
    *(u32x4*)(d.dst + (size_t)(d.n0 + n) * d.ld_dst + d.k0 + kc * 8) = o;
  }
  __syncthreads();
}

constexpr int T_AB = 416, T_CD = 224, T_QU = 36, T_KVU = 32, T_O = 128, T_GU = 704, T_D = 352;
constexpr int E_AB = 2 * T_AB, E_CD = E_AB + 2 * T_CD, E_QU = E_CD + 2 * T_QU, E_KVU = E_QU + 2 * T_KVU,
              E_O = E_KVU + 4 * T_O, E_GU = E_O + 4 * T_GU, E_D = E_GU + 4 * T_D;

DI TDesc tdesc(const P& p, int task) {
  TDesc d;
  d.g1 = nullptr; d.kscale = nullptr; d.kind = 0; d.pad_ = 0;
  if (task < E_AB) {
    const int e = task / T_AB, r = task % T_AB, kt = r / 26, nt = r % 26;
    d.g0 = p.w_in_ab + (size_t)e * 1024 * 3328; d.ld_src = 3328; d.k0 = kt * 64; d.n0 = nt * 128;
    d.dst = WSP(u16, O_WAB) + (size_t)e * 3328 * 1024; d.ld_dst = 1024;
  } else if (task < E_CD) {
    const int q = task - E_AB, o = q / T_CD, r = q % T_CD, kt = r / 14, nt = r % 14;
    d.g0 = p.w_in_cd + (size_t)o * 1024 * 1696; d.ld_src = 1696; d.kind = 1; d.k0 = kt * 64; d.n0 = nt * 128;
    d.dst = WSP(u16, O_WCD) + (size_t)o * 1792 * 1024; d.ld_dst = 1024;
  } else if (task < E_QU) {
    const int q = task - E_CD, o = q / T_QU, r = q % T_QU, kt = r / 6, nt = r % 6;
    d.g0 = p.c_w_q_up + (size_t)o * 384 * 768; d.ld_src = 768; d.k0 = kt * 64; d.n0 = nt * 128;
    d.dst = WSP(u16, O_WQU) + (size_t)o * 768 * 384; d.ld_dst = 384; d.kscale = p.c_q_norm + o * 384;
  } else if (task < E_KVU) {
    const int q = task - E_QU, o = q / T_KVU, r = q % T_KVU, kt = r / 8, nt = r % 8;
    d.g0 = p.c_w_kv_up + (size_t)o * 256 * 1024; d.ld_src = 1024; d.k0 = kt * 64; d.n0 = nt * 128;
    d.dst = WSP(u16, O_WKVU) + (size_t)o * 1024 * 256; d.ld_dst = 256;
  } else if (task < E_O) {
    const int q = task - E_KVU, l = q / T_O, r = q % T_O, kt = r / 8, nt = r % 8;
    d.g0 = p.w_out + (size_t)l * 1024 * 1024; d.ld_src = 1024; d.k0 = kt * 64; d.n0 = nt * 128;
    d.dst = WSP(u16, O_WO) + (size_t)l * 1024 * 1024; d.ld_dst = 1024;
  } else if (task < E_GU) {
    const int q = task - E_O, l = q / T_GU, r = q % T_GU, kt = r / 44, nt = r % 44;
    d.g0 = p.w_ffn_gate + (size_t)l * 1024 * 2816; d.g1 = p.w_ffn_up + (size_t)l * 1024 * 2816; d.ld_src = 2816; d.kind = 2;
    d.k0 = kt * 64; d.n0 = nt * 128; d.dst = WSP(u16, O_WGU) + (size_t)l * 5632 * 1024; d.ld_dst = 1024;
  } else {
    const int q = task - E_GU, l = q / T_D, r = q % T_D, kt = r / 8, nt = r % 8;
    d.g0 = p.w_ffn_down + (size_t)l * 2816 * 1024; d.ld_src = 1024; d.k0 = kt * 64; d.n0 = nt * 128;
    d.dst = WSP(u16, O_WD) + (size_t)l * 1024 * 2816; d.ld_dst = 2816;
  }
  return d;
}
DI void transpose_task(const P& p, float* sm, int task) {
  const TDesc d = tdesc(p, task);
  float v[32];
  transpose_load(d, v);
  transpose_finish(sm, d, v);
}

constexpr int NDEF0 = 2 * (T_O + T_GU + T_D) + T_CD + T_QU + T_KVU + T_AB, NDEF1 = NDEF0 - T_AB;
DI int deferred_task(int e, int q) {
  const int l0 = 2 * e;
  if (q < T_O) return E_KVU + l0 * T_O + q;
  q -= T_O;
  if (q < T_GU) return E_O + l0 * T_GU + q;
  q -= T_GU;
  if (q < T_D) return E_GU + l0 * T_D + q;
  q -= T_D;
  if (q < T_CD) return E_AB + e * T_CD + q;
  q -= T_CD;
  if (q < T_QU) return E_CD + e * T_QU + q;
  q -= T_QU;
  if (q < T_KVU) return E_QU + e * T_KVU + q;
  q -= T_KVU;
  if (q < T_O) return E_KVU + (l0 + 1) * T_O + q;
  q -= T_O;
  if (q < T_GU) return E_O + (l0 + 1) * T_GU + q;
  q -= T_GU;
  if (q < T_D) return E_GU + (l0 + 1) * T_D + q;
  q -= T_D;
  return T_AB + q;
}

DI void prep_phase(const P& p, char* smem) {
  float* sm = (float*)smem;
  const int t = tid_opaque();
  for (int task0 = bid_opaque(); task0 < 768 + T_AB; task0 += gridDim.x) {
    if (task0 >= 768) {
      transpose_task(p, sm, task0 - 768);
    } else {
      const int l = task0 / 192, rem = task0 % 192, cb = rem >> 1, kh = rem & 1;
      float* sc = sm;
      float* red = sm + 9 * 512;
      for (int idx = t; idx < 4608; idx += 256) {
        const int m = idx >> 9, k = kh * 512 + (idx & 511);
        const float cv = (m == 0) ? p.c_ctx[k] : p.c[(m - 1) * 1024 + k];
        sc[idx] = silu_f(cv);
      }
      __syncthreads();
      const int cc = t & 63, kq = t >> 6;
      const float* w = p.w_ada + ((size_t)l * 1024 + kh * 512 + kq * 128) * 6144 + cb * 64 + cc;
      float acc[9];
#pragma unroll
      for (int m = 0; m < 9; ++m) acc[m] = 0.f;
#pragma unroll 16
      for (int k = 0; k < 128; ++k) {
        const float wv = __builtin_nontemporal_load(w + (size_t)k * 6144);
#pragma unroll
        for (int m = 0; m < 9; ++m) acc[m] += sc[m * 512 + kq * 128 + k] * wv;
      }
#pragma unroll
      for (int m = 0; m < 9; ++m) red[(kq * 9 + m) * 64 + cc] = acc[m];
      __syncthreads();
      for (int idx = t; idx < 576; idx += 256) {
        const int m = idx >> 6, c2 = idx & 63;
        float s2 = red[(0 * 9 + m) * 64 + c2] + red[(1 * 9 + m) * 64 + c2] + red[(2 * 9 + m) * 64 + c2] +
                   red[(3 * 9 + m) * 64 + c2];
        if (kh == 0) s2 += p.b_ada[l * 6144 + cb * 64 + c2];
        atomicAdd(WSP(float, O_MOD) + ((size_t)l * 9 + m) * 6144 + cb * 64 + c2, s2);
      }
      __syncthreads();
    }
  }
  const int gt = bid_opaque() * 256 + t, ngt = gridDim.x * 256;
  for (int i = gt; i < 64 * 16; i += ngt) {
    const int pos = i >> 4, j = i & 15;
    const float inv = powf(10000.f, -(float)j / 16.f);
    const float a = (float)pos * inv;
    WSP(float, O_CS64)[2 * i] = cosf(a);
    WSP(float, O_CS64)[2 * i + 1] = sinf(a);
  }
  for (int i = gt; i < 64 * 8; i += ngt) {
    const int pos = i >> 3, j = i & 7;
    const float inv = powf(10000.f, -(float)j / 8.f);
    const float a = (float)pos * inv;
    WSP(float, O_CS32)[2 * i] = cosf(a);
    WSP(float, O_CS32)[2 * i + 1] = sinf(a);
  }
  for (int i = gt; i < 2048; i += ngt) {
    const int e = i >> 10, r = i & 1023;
    float v = 0.f;
    if (e == 1) v = 1.f / (1.f + expf(p.b_lb[r] - p.b_lb[1024 + r]));
    WSP(float, O_LBT)[i] = v;
  }
  for (int i4 = gt; i4 < 2 * 8 * 512 * 32; i4 += ngt) {
    const int i = i4 * 4;
    const int c = i & 127, pp = (i >> 7) & 511, b = (i >> 16) & 7, e = i >> 19;
    const f32x4 v = *(const f32x4*)(p.cache_a_k + (((size_t)b * 2 + e) * 512 + pp) * 128 + c);
    u32x2 o;
    o[0] = pack2(v[0], v[1]);
    o[1] = pack2(v[2], v[3]);
    *(u32x2*)(WSP(u16, O_KCA) + i) = o;
  }
  for (int i = gt; i < 2 * 8 * 64 * 128; i += ngt) {
    const int c = i & 127, pc = (i >> 7) & 63, b = (i >> 13) & 7, e = i >> 16;
    const float* src = p.cache_a_v + (((size_t)b * 2 + e) * 512 + pc * 8) * 128 + c;
    u32x4 o;
#pragma unroll
    for (int q = 0; q < 4; ++q) o[q] = pack2(src[(2 * q) * 128], src[(2 * q + 1) * 128]);
    *(u32x4*)(WSP(u16, O_VTAL) + ((size_t)((e * 8 + b) * 2 + (c >> 6)) * 64 + (c & 63)) * 1536 + 1024 + pc * 8) = o;
  }
  for (int i4 = gt; i4 < 2 * 8 * 512 * 64; i4 += ngt) {
    const int i = i4 * 4;
    const int c = i & 255, pp = (i >> 8) & 511, b = (i >> 17) & 7, o = i >> 20;
    const f32x4 v = *(const f32x4*)(p.cache_d_k + (((size_t)b * 2 + o) * 512 + pp) * 256 + c);
    u32x2 ov;
    ov[0] = pack2(v[0], v[1]);
    ov[1] = pack2(v[2], v[3]);
    *(u32x2*)(WSP(u16, O_KCD) + i) = ov;
  }
  for (int i = gt; i < 2 * 8 * 64 * 256; i += ngt) {
    const int c = i & 255, pc = (i >> 8) & 63, b = (i >> 14) & 7, o = i >> 17;
    const float* src = p.cache_d_v + (((size_t)b * 2 + o) * 512 + pc * 8) * 256 + c;
    u32x4 ov;
#pragma unroll
    for (int q = 0; q < 4; ++q) ov[q] = pack2(src[(2 * q) * 256], src[(2 * q + 1) * 256]);
    *(u32x4*)(WSP(u16, O_VTDL) + ((size_t)((o * 8 + b) * 4 + (c >> 6)) * 64 + (c & 63)) * 1536 + 1024 + pc * 8) = ov;
  }
  for (int i4 = gt; i4 < 2 * 8 * 512 * 8; i4 += ngt) {
    const int i = i4 * 4;
    const int c = i & 31, pp = (i >> 5) & 511, b = (i >> 14) & 7, o = i >> 17;
    const f32x4 v = *(const f32x4*)(p.cache_c_pe + (((size_t)b * 2 + o) * 512 + pp) * 32 + c);
    u32x2 ov;
    ov[0] = pack2(v[0], v[1]);
    ov[1] = pack2(v[2], v[3]);
    *(u32x2*)(WSP(u16, O_PECTX) + i) = ov;
  }
}

DI const float* x_input_row(const P& p, int R) {
  return R < NPR ? p.x_prompt + (size_t)R * 1024 : p.x_sample + (size_t)(R - NPR) * 1024;
}

DI void h0_phase(const P& p) {
  const int lane = tid_opaque() & 63;
  const int gw = bid_opaque() * 4 + (tid_opaque() >> 6), nw = gridDim.x * 4;
  for (int R0 = gw * 4; R0 < NROWS; R0 += nw * 4) {
    const float* md = WSP(float, O_MOD) + (size_t)(0 * 9 + mod_index(R0)) * 6144;
    f32x4 v[4][4];
#pragma unroll
    for (int rr = 0; rr < 4; ++rr) {
      const float* xr = x_input_row(p, R0 + rr);
#pragma unroll
      for (int j = 0; j < 4; ++j) v[rr][j] = *(const f32x4*)(xr + j * 256 + lane * 4);
    }
#pragma unroll
    for (int j = 0; j < 4; ++j) {
      const int c = j * 256 + lane * 4;
      const f32x4 sh = *(const f32x4*)(md + c), scl = *(const f32x4*)(md + 1024 + c);
#pragma unroll
      for (int rr = 0; rr < 4; ++rr) {
        u32x2 o;
        o[0] = pack2(v[rr][j][0] * (1.f + scl[0]) + sh[0], v[rr][j][1] * (1.f + scl[1]) + sh[1]);
        o[1] = pack2(v[rr][j][2] * (1.f + scl[2]) + sh[2], v[rr][j][3] * (1.f + scl[3]) + sh[3]);
        *(u32x2*)(WSP(u16, O_HM) + (size_t)(R0 + rr) * 1024 + c) = o;
      }
    }
  }
}

DI void ln_phase(const P& p, int l, int which) {
  const int lane = tid_opaque() & 63;
  const int gw = bid_opaque() * 4 + (tid_opaque() >> 6), nw = gridDim.x * 4;
  const float* g = p.ln_g + (l * 2 + which) * 1024;
  const float* bb = p.ln_b + (l * 2 + which) * 1024;
  const bool has_h = (which == 0) || (l < 3);
  const bool full = !has_h;
  const int ml = (which == 0) ? l : l + 1;
  const int so = (which == 0) ? 3 : 0;
  for (int R0 = gw * 4; R0 < NROWS; R0 += nw * 4) {
    f32x4 v[4][4];
    float s[4], q[4], mean[4], rs[4];
#pragma unroll
    for (int rr = 0; rr < 4; ++rr) {
      const float* xr = p.out + (size_t)(R0 + rr) * 1024;
#pragma unroll
      for (int j = 0; j < 4; ++j) v[rr][j] = *(const f32x4*)(xr + j * 256 + lane * 4);
    }
#pragma unroll
    for (int rr = 0; rr < 4; ++rr) {
      s[rr] = 0.f;
#pragma unroll
      for (int j = 0; j < 4; ++j) s[rr] += v[rr][j][0] + v[rr][j][1] + v[rr][j][2] + v[rr][j][3];
    }
#pragma unroll
    for (int o = 32; o >= 1; o >>= 1)
#pragma unroll
      for (int rr = 0; rr < 4; ++rr) s[rr] += __shfl_xor(s[rr], o);
#pragma unroll
    for (int rr = 0; rr < 4; ++rr) {
      mean[rr] = s[rr] * (1.f / 1024.f);
      q[rr] = 0.f;
#pragma unroll
      for (int j = 0; j < 4; ++j)
#pragma unroll
        for (int k = 0; k < 4; ++k) {
          v[rr][j][k] -= mean[rr];
          q[rr] += v[rr][j][k] * v[rr][j][k];
        }
    }
#pragma unroll
    for (int o = 32; o >= 1; o >>= 1)
#pragma unroll
      for (int rr = 0; rr < 4; ++rr) q[rr] += __shfl_xor(q[rr], o);
#pragma unroll
    for (int rr = 0; rr < 4; ++rr) rs[rr] = rsqrtf(q[rr] * (1.f / 1024.f) + 1e-5f);
    if (!full && lane < 4) {
      f32v2 st;
      st[0] = lane == 0 ? mean[0] : lane == 1 ? mean[1] : lane == 2 ? mean[2] : mean[3];
      st[1] = lane == 0 ? rs[0] : lane == 1 ? rs[1] : lane == 2 ? rs[2] : rs[3];
      *(f32v2*)(WSP(float, O_ST) + (size_t)(R0 + lane) * 2) = st;
    }
    const float* md = WSP(float, O_MOD) + (size_t)((has_h ? ml : 0) * 9 + mod_index(R0)) * 6144;
#pragma unroll
    for (int j = 0; j < 4; ++j) {
      const int c = j * 256 + lane * 4;
      const f32x4 gg = *(const f32x4*)(g + c), bv = *(const f32x4*)(bb + c);
      f32x4 sh, scl;
      if (has_h) {
        sh = *(const f32x4*)(md + so * 1024 + c);
        scl = *(const f32x4*)(md + (so + 1) * 1024 + c);
      }
#pragma unroll
      for (int rr = 0; rr < 4; ++rr) {
        f32x4 x;
#pragma unroll
        for (int k = 0; k < 4; ++k) x[k] = v[rr][j][k] * rs[rr] * gg[k] + bv[k];
        if (full) *(f32x4*)(p.out + (size_t)(R0 + rr) * 1024 + c) = x;
        if (has_h) {
          u32x2 o;
          o[0] = pack2(x[0] * (1.f + scl[0]) + sh[0], x[1] * (1.f + scl[1]) + sh[1]);
          o[1] = pack2(x[2] * (1.f + scl[2]) + sh[2], x[3] * (1.f + scl[3]) + sh[3]);
          *(u32x2*)(WSP(u16, O_HM) + (size_t)(R0 + rr) * 1024 + c) = o;
        }
      }
    }
  }
}

DI void hfin_phase(const P& p, int e) {
  const int lane = tid_opaque() & 63;
  const int gw = bid_opaque() * 4 + (tid_opaque() >> 6), nw = gridDim.x * 4;
  const float* of = WSP(float, O_OFB);
  const float* ob = of + (size_t)NROWS * 512;
  const float* gn = p.b_gnorm + e * 128;
  for (int R = gw; R < NROWS; R += nw) {
    const int c = lane * 8;
    float o[8];
    float ss = 0.f;
#pragma unroll
    for (int j = 0; j < 2; ++j) {
      const f32x4 a = *(const f32x4*)(of + (size_t)R * 512 + c + 4 * j);
      const f32x4 b = *(const f32x4*)(ob + (size_t)R * 512 + c + 4 * j);
#pragma unroll
      for (int k = 0; k < 4; ++k) {
        o[4 * j + k] = a[k] + b[k];
        ss += o[4 * j + k] * o[4 * j + k];
      }
    }
    ss += __shfl_xor(ss, 1);
    ss += __shfl_xor(ss, 2);
    ss += __shfl_xor(ss, 4);
    ss += __shfl_xor(ss, 8);
    const float r = rsqrtf(ss * (1.f / 128.f) + 1e-6f);
    const u32x4 gbv = *(const u32x4*)(WSP(u16, O_GB) + (size_t)R * 512 + c);
    const int v0 = c & 127;
    u32x4 outv;
#pragma unroll
    for (int q = 0; q < 4; ++q) {
      const float g0 = bf2f((u16)(gbv[q] & 0xffff)), g1 = bf2f((u16)(gbv[q] >> 16));
      outv[q] = pack2(o[2 * q] * r * gn[v0 + 2 * q] * g0, o[2 * q + 1] * r * gn[v0 + 2 * q + 1] * g1);
    }
    *(u32x4*)(WSP(u16, O_HM) + (size_t)R * 1024 + 512 + c) = outv;
  }
}

DI void post_odd_phase(const P& p, int o) {
  const int lane = tid_opaque() & 63;
  const int gw = bid_opaque() * 4 + (tid_opaque() >> 6), nw = gridDim.x * 4;
  const float* cs64 = WSP(float, O_CS64);
  const float* cs32 = WSP(float, O_CS32);
  u16 rcq[6], rkpe;
  u32x2 rckv, rkd;
  u32x4 rqd;
#define POST_LOAD(RR)                                                        \
  {                                                                          \
    const u16* pr_ = WSP(u16, O_PROJ) + (size_t)(RR) * 1792;                 \
    _Pragma("unroll") for (int j = 0; j < 6; ++j) rcq[j] = pr_[lane + 64 * j]; \
    rckv = *(const u32x2*)(pr_ + 384 + lane * 4);                            \
    rqd = *(const u32x4*)(pr_ + 640 + lane * 8);                             \
    rkd = *(const u32x2*)(pr_ + 1152 + lane * 4);                            \
    rkpe = pr_[1664 + (lane & 31)];                                          \
  }
  if (gw < NROWS) POST_LOAD(gw)
  for (int R = gw; R < NROWS; R += nw) {
    u16 ccq[6];
#pragma unroll
    for (int j = 0; j < 6; ++j) ccq[j] = rcq[j];
    const u32x2 cckv = rckv, ckd = rkd;
    const u32x4 cqd = rqd;
    const u16 ckpe = rkpe;
    { const int Rn = R + nw < NROWS ? R + nw : R; POST_LOAD(Rn) }
    const bool lat = R >= NPR;
    const int b = lat ? (R - NPR) >> 10 : R >> 8;
    const int tk = lat ? (R - NPR) & 1023 : R & 255;
    const int prow = tk >> 6, pcol = tk & 63;
    {
      float ss = 0.f;
#pragma unroll
      for (int j = 0; j < 6; ++j) {
        const float v = bf2f(ccq[j]);
        ss += v * v;
      }
      ss = wave_sum(ss);
      if (lane == 0) WSP(float, O_RCQ)[R] = rsqrtf(ss * (1.f / 384.f) + 1e-6f);
    }
    {
      const u32x2 raw = cckv;
      float v[4] = {bf2f((u16)(raw[0] & 0xffff)), bf2f((u16)(raw[0] >> 16)), bf2f((u16)(raw[1] & 0xffff)),
                    bf2f((u16)(raw[1] >> 16))};
      float ss = v[0] * v[0] + v[1] * v[1] + v[2] * v[2] + v[3] * v[3];
      ss = wave_sum(ss);
      const float r = rsqrtf(ss * (1.f / 256.f) + 1e-6f);
      const f32x4 g = *(const f32x4*)(p.c_kv_norm + o * 256 + lane * 4);
      f32x4 y;
#pragma unroll
      for (int k = 0; k < 4; ++k) y[k] = v[k] * r * g[k];
      u32x2 ov;
      ov[0] = pack2(y[0], y[1]);
      ov[1] = pack2(y[2], y[3]);
      *(u32x2*)(WSP(u16, O_CKVN) + (size_t)R * 256 + lane * 4) = ov;
      if (!lat) *(f32x4*)(p.out + OUT_CKV + (((size_t)b * 2 + o) * 256 + tk) * 256 + lane * 4) = y;
    }
    {
      const u32x4 raw = cqd;
      float v[8];
#pragma unroll
      for (int q = 0; q < 4; ++q) {
        v[2 * q] = bf2f((u16)(raw[q] & 0xffff));
        v[2 * q + 1] = bf2f((u16)(raw[q] >> 16));
      }
      float ss = 0.f;
#pragma unroll
      for (int k = 0; k < 8; ++k) ss += v[k] * v[k];
      ss += __shfl_xor(ss, 1);
      ss += __shfl_xor(ss, 2);
      ss += __shfl_xor(ss, 4);
      const float r = rsqrtf(ss * (1.f / 64.f) + 1e-6f);
      const int l8 = lane & 7;
#pragma unroll
      for (int k = 0; k < 8; ++k) v[k] = v[k] * r * p.d_q_norm[o * 64 + l8 * 8 + k];
      const bool first = (l8 & 2) == 0;
      const int pos = (l8 < 4) ? prow : pcol;
      u32x4 ov;
      float y[8];
#pragma unroll
      for (int k = 0; k < 8; ++k) {
        const float pv = __shfl_xor(v[k], 2);
        const int i = (l8 & 1) * 8 + k;
        const float cc = cs64[(pos * 16 + i) * 2], sn = cs64[(pos * 16 + i) * 2 + 1];
        const float rot = first ? v[k] * cc - pv * sn : v[k] * cc + pv * sn;
        y[k] = lat ? rot : v[k];
      }
#pragma unroll
      for (int q = 0; q < 4; ++q) ov[q] = pack2(y[2 * q], y[2 * q + 1]);
      *(u32x4*)(WSP(u16, O_QD) + (size_t)R * 512 + lane * 8) = ov;
    }
    {
      const u32x2 raw = ckd;
      float v[4] = {bf2f((u16)(raw[0] & 0xffff)), bf2f((u16)(raw[0] >> 16)), bf2f((u16)(raw[1] & 0xffff)),
                    bf2f((u16)(raw[1] >> 16))};
      float ss = v[0] * v[0] + v[1] * v[1] + v[2] * v[2] + v[3] * v[3];
      ss += __shfl_xor(ss, 1);
      ss += __shfl_xor(ss, 2);
      ss += __shfl_xor(ss, 4);
      ss += __shfl_xor(ss, 8);
      const float r = rsqrtf(ss * (1.f / 64.f) + 1e-6f);
      const int l16 = lane & 15;
      f32x4 y;
#pragma unroll
      for (int k = 0; k < 4; ++k) y[k] = v[k] * r * p.d_k_norm[o * 64 + l16 * 4 + k];
      if (!lat) *(f32x4*)(p.out + OUT_DK + (((size_t)b * 2 + o) * 256 + tk) * 256 + lane * 4) = y;
      const bool first = (l16 & 4) == 0;
      const int pos = (l16 < 8) ? prow : pcol;
      float z[4];
#pragma unroll
      for (int k = 0; k < 4; ++k) {
        const float pv = __shfl_xor(y[k], 4);
        const int i = (l16 & 3) * 4 + k;
        const float cc = cs64[(pos * 16 + i) * 2], sn = cs64[(pos * 16 + i) * 2 + 1];
        const float rot = first ? y[k] * cc - pv * sn : y[k] * cc + pv * sn;
        z[k] = lat ? rot : y[k];
      }
      u32x2 ov;
      ov[0] = pack2(z[0], z[1]);
      ov[1] = pack2(z[2], z[3]);
      *(u32x2*)(WSP(u16, O_KD) + (size_t)R * 256 + lane * 4) = ov;
    }
    {
      const float v = bf2f(ckpe);
      const float pv = __shfl_xor(v, 8);
      const int l32 = lane & 31;
      const bool first = (l32 & 8) == 0;
      const int pos = (l32 < 16) ? prow : pcol;
      const int i = l32 & 7;
      const float cc = cs32[(pos * 8 + i) * 2], sn = cs32[(pos * 8 + i) * 2 + 1];
      const float rot = first ? v * cc - pv * sn : v * cc + pv * sn;
      if (lane < 32) {
        WSP(u16, O_KPE)[(size_t)R * 32 + lane] = f2bf(lat ? rot : v);
        if (!lat) p.out[OUT_CPE + (((size_t)b * 2 + o) * 256 + tk) * 32 + lane] = v;
      }
    }
  }
#undef POST_LOAD
  const int gt = bid_opaque() * 256 + tid_opaque(), ngt = gridDim.x * 256;
  for (int i4 = gt; i4 < 8 * 512 * 64; i4 += ngt) {
    const int i = i4 * 4;
    const int c = i & 255, pp = (i >> 8) & 511, b = i >> 17;
    const f32x4 v = *(const f32x4*)(p.cache_c_kv + (((size_t)b * 2 + o) * 512 + pp) * 256 + c);
    u32x2 ov;
    ov[0] = pack2(v[0], v[1]);
    ov[1] = pack2(v[2], v[3]);
    *(u32x2*)(WSP(u16, O_CKVN) + (size_t)16384 * 256 + i) = ov;
  }
}

enum { G_EVEN_IN = 0, G_ODD_IN, G_UPS, G_OUTP, G_FFNUP, G_FFNDN };
enum { EP_EVEN_IN = 0, EP_ODD_IN, EP_QUP, EP_KVUP, EP_RESID, EP_SWIGLU };

constexpr int G_LDS_STRIDE = 72;

DI void gemm_phase(const P& p, char* smem, int kind, int l) {
  u16* As = (u16*)smem;
  u16* Bs = As + 2 * 128 * G_LDS_STRIDE;
  const int eo = l >> 1;
  int ntiles_total, NT1 = 1, split = 0x7fffffff;
  switch (kind) {
    case G_EVEN_IN: NT1 = 26; ntiles_total = 128 * 26; break;
    case G_ODD_IN: NT1 = 14; ntiles_total = 128 * 14; break;
    case G_UPS: NT1 = 6; split = 128 * 6; ntiles_total = 128 * 6 + 160 * 8; break;
    case G_OUTP: NT1 = 8; ntiles_total = 128 * 8; break;
    case G_FFNUP: NT1 = 44; ntiles_total = 128 * 44; break;
    default: NT1 = 8; ntiles_total = 128 * 8; break;
  }
  const int bid = bid_opaque();
  const int xcd = bid & 7, slot = bid >> 3, nslots = gridDim.x >> 3;
  const int per_xcd1 = (kind == G_UPS) ? 16 * 6 : ntiles_total / 8;
  const int per_xcd = (kind == G_UPS) ? 16 * 6 + 20 * 8 : per_xcd1;
  (void)split;
  u32x4 ra0[4], rb0[4], ra1[4], rb1[4];
  if ((bid >> 8) & 1) { __builtin_amdgcn_s_sleep(12); }
  bool first_tile = true;
#define TILE_DESC(J, M0, N0, AP, BP, LDA, LDB, KK, EPI)                                                   \
  {                                                                                                       \
    const bool sec_ = (J) >= per_xcd1;                                                                    \
    const int jj_ = sec_ ? (J) - per_xcd1 : (J);                                                          \
    const int NT_ = sec_ ? 8 : NT1;                                                                       \
    const int mper_ = sec_ ? 20 : 16;                                                                     \
    const int mg_ = jj_ / (8 * NT_), rem_ = jj_ % (8 * NT_);                                              \
    const int mgsz_ = (mper_ - mg_ * 8) < 8 ? (mper_ - mg_ * 8) : 8;                                      \
    const int nn_ = rem_ / mgsz_, mi2_ = rem_ % mgsz_;                                                    \
    M0 = (xcd * mper_ + mg_ * 8 + mi2_) * 128;                                                            \
    N0 = nn_ * 128;                                                                                       \
    switch (kind) {                                                                                       \
      case G_EVEN_IN:                                                                                     \
        AP = WSP(u16, O_HM); LDA = 1024; BP = WSP(u16, O_WAB) + (size_t)eo * 3328 * 1024; LDB = 1024; KK = 1024; EPI = EP_EVEN_IN; break; \
      case G_ODD_IN:                                                                                      \
        AP = WSP(u16, O_HM); LDA = 1024; BP = WSP(u16, O_WCD) + (size_t)eo * 1792 * 1024; LDB = 1024; KK = 1024; EPI = EP_ODD_IN; break; \
      case G_UPS:                                                                                         \
        if (!sec_) { AP = WSP(u16, O_PROJ); LDA = 1792; BP = WSP(u16, O_WQU) + (size_t)eo * 768 * 384; LDB = 384; KK = 384; EPI = EP_QUP; } \
        else { AP = WSP(u16, O_CKVN); LDA = 256; BP = WSP(u16, O_WKVU) + (size_t)eo * 1024 * 256; LDB = 256; KK = 256; EPI = EP_KVUP; } \
        break;                                                                                            \
      case G_OUTP:                                                                                        \
        AP = WSP(u16, O_HM); LDA = 1024; BP = WSP(u16, O_WO) + (size_t)l * 1024 * 1024; LDB = 1024; KK = 1024; EPI = EP_RESID; break; \
      case G_FFNUP:                                                                                       \
        AP = WSP(u16, O_HM); LDA = 1024; BP = WSP(u16, O_WGU) + (size_t)l * 5632 * 1024; LDB = 1024; KK = 1024; EPI = EP_SWIGLU; break; \
      default:                                                                                            \
        AP = WSP(u16, O_ACT); LDA = 2816; BP = WSP(u16, O_WD) + (size_t)l * 1024 * 2816; LDB = 2816; KK = 2816; EPI = EP_RESID; break; \
    }                                                                                                     \
  }
  for (int j = slot; j < per_xcd; j += nslots) {
    const int t = tid_opaque(), lane = t & 63, wave = t >> 6;
    const int wm = wave >> 1, wn = wave & 1, r = lane & 31, h = lane >> 5;
    const u16 *A, *Bt, *An, *Btn;
    int lda, ldb, K, m0, n0, epi, ldan, ldbn, Kn, m0n, n0n, epin;
    TILE_DESC(j, m0, n0, A, Bt, lda, ldb, K, epi)
    {
      const int jn = (j + nslots < per_xcd) ? j + nslots : j;
      TILE_DESC(jn, m0n, n0n, An, Btn, ldan, ldbn, Kn, epin)
      (void)Kn; (void)epin;
    }
    f32x16 acc[2][2];
#pragma unroll
    for (int a = 0; a < 2; ++a)
#pragma unroll
      for (int b = 0; b < 2; ++b) acc[a][b] = zero16();
    const int KT = K >> 6;
    const int lrow = t >> 3, lkc = (t & 7) * 8;
    const u16* Ag = A + (size_t)m0 * lda;
    const u16* Bg = Bt + (size_t)n0 * ldb;
    const u16* Agn = An + (size_t)m0n * ldan;
    const u16* Bgn = Btn + (size_t)n0n * ldbn;
    const unsigned loA = (unsigned)(lrow * lda + lkc) * 2u, loB = (unsigned)(lrow * ldb + lkc) * 2u;
    const unsigned loAn = (unsigned)(lrow * ldan + lkc) * 2u, loBn = (unsigned)(lrow * ldbn + lkc) * 2u;
#define G_LOAD(RA, RB, V)                                                           \
  {                                                                                 \
    const int v_ = (V);                                                             \
    const bool nx_ = v_ >= KT;                                                      \
    const int kk_ = (nx_ ? v_ - KT : v_) * 128;                                     \
    const auto ra_ = __builtin_amdgcn_make_buffer_rsrc((void*)(nx_ ? Agn : Ag), (short)0, 0x40000000, 0x00020000); \
    const auto rb_ = __builtin_amdgcn_make_buffer_rsrc((void*)(nx_ ? Bgn : Bg), (short)0, 0x40000000, 0x00020000); \
    const int la_ = (nx_ ? ldan : lda) * 64, lb_ = (nx_ ? ldbn : ldb) * 64;         \
    const unsigned oa_ = nx_ ? loAn : loA, ob_ = nx_ ? loBn : loB;                  \
    _Pragma("unroll") for (int i = 0; i < 4; ++i) {                                 \
      RA[i] = __builtin_amdgcn_raw_buffer_load_b128(ra_, oa_, kk_ + i * la_, 0);    \
      RB[i] = __builtin_amdgcn_raw_buffer_load_b128(rb_, ob_, kk_ + i * lb_, 0);    \
    }                                                                               \
  }
#define G_STORE(RA, RB, BUF)                                                        \
  _Pragma("unroll") for (int i = 0; i < 4; ++i) {                                   \
    *(u32x4*)(As + (BUF) * 128 * G_LDS_STRIDE + (lrow + 32 * i) * G_LDS_STRIDE + lkc) = RA[i]; \
    *(u32x4*)(Bs + (BUF) * 128 * G_LDS_STRIDE + (lrow + 32 * i) * G_LDS_STRIDE + lkc) = RB[i]; \
  }
#define G_FRAGS(BUF)                                                                \
  {                                                                                 \
    const u16* Ab = As + (BUF) * 128 * G_LDS_STRIDE + (wm * 64 + r) * G_LDS_STRIDE + h * 8; \
    const u16* Bb = Bs + (BUF) * 128 * G_LDS_STRIDE + (wn * 64 + r) * G_LDS_STRIDE + h * 8; \
    _Pragma("unroll") for (int ks = 0; ks < 4; ++ks) {                              \
      fa[ks][0] = *(const bf16x8*)(Ab + ks * 16);                                   \
      fb[ks][0] = *(const bf16x8*)(Bb + ks * 16);                                   \
      fa[ks][1] = *(const bf16x8*)(Ab + 32 * G_LDS_STRIDE + ks * 16);               \
      fb[ks][1] = *(const bf16x8*)(Bb + 32 * G_LDS_STRIDE + ks * 16);               \
    }                                                                               \
  }
#define G_MFMAS()                                                                   \
  _Pragma("unroll") for (int ks = 0; ks < 4; ++ks) {                                \
    acc[0][0] = MFMA(fa[ks][0], fb[ks][0], acc[0][0]);                              \
    acc[0][1] = MFMA(fa[ks][0], fb[ks][1], acc[0][1]);                              \
    acc[1][0] = MFMA(fa[ks][1], fb[ks][0], acc[1][0]);                              \
    acc[1][1] = MFMA(fa[ks][1], fb[ks][1], acc[1][1]);                              \
  }
#define G_INTERLEAVE()                                                              \
  _Pragma("unroll") for (int q = 0; q < 8; ++q) {                                   \
    __builtin_amdgcn_sched_group_barrier(0x008, 1, 0);                              \
    __builtin_amdgcn_sched_group_barrier(0x200, 1, 0);                              \
  }                                                                                 \
  _Pragma("unroll") for (int q = 0; q < 8; ++q) {                                   \
    __builtin_amdgcn_sched_group_barrier(0x008, 1, 0);                              \
    __builtin_amdgcn_sched_group_barrier(0x020, 1, 0);                              \
  }
    bf16x8 fa[4][2], fb[4][2];
    if (first_tile) {
      first_tile = false;
      G_LOAD(ra0, rb0, 0)
      G_LOAD(ra1, rb1, 1)
      G_STORE(ra0, rb0, 0)
      G_LOAD(ra0, rb0, 2)
      __builtin_amdgcn_sched_barrier(0);
      __syncthreads();
    }
    for (int kt = 0; kt < KT; kt += 2) {
      G_FRAGS(0)
      __builtin_amdgcn_sched_barrier(0);
      G_STORE(ra1, rb1, 1)
      G_LOAD(ra1, rb1, kt + 3)
      G_MFMAS()
      G_INTERLEAVE()
      __builtin_amdgcn_sched_barrier(0);
      __syncthreads();
      G_FRAGS(1)
      __builtin_amdgcn_sched_barrier(0);
      G_STORE(ra0, rb0, 0)
      G_LOAD(ra0, rb0, kt + 4)
      G_MFMAS()
      G_INTERLEAVE()
      __builtin_amdgcn_sched_barrier(0);
      __syncthreads();
    }
#undef G_FRAGS
#undef G_MFMAS
#undef G_INTERLEAVE
#undef G_LOAD
#undef G_STORE
    const int rowb = m0 + wm * 64;
    const int colb = n0 + wn * 64;
    const bool lat = m0 >= NPR && m0 < NROWS;
    const int mi_mod = mod_index(m0 < NROWS ? m0 : 0);
    if (epi == EP_RESID) {
      const int gsel = (kind == G_OUTP) ? 2 : 5;
      const bool from_input = (kind == G_OUTP) && (l == 0);
      const int pln = (kind == G_OUTP) ? (l - 1) * 2 + 1 : l * 2;
      const float* md = WSP(float, O_MOD) + (size_t)(l * 9 + mi_mod) * 6144 + gsel * 1024;
      const char* xb0 = (const char*)(from_input ? x_input_row(p, m0) : p.out + (size_t)m0 * 1024);
      char* ob0 = (char*)(p.out + (size_t)m0 * 1024);
      const char* st0 = (const char*)WSP(float, O_ST);
      const int col0 = colb + r, col1 = col0 + 32;
      const unsigned lo0 = ((unsigned)(wm * 64 + 4 * h) * 1024u + (unsigned)col0) * 4u;
      const unsigned ls0 = (unsigned)(rowb + 4 * h) * 8u;
      const float gate0 = md[col0], gate1 = md[col1];
      float g0 = 1.f, g1 = 1.f, b0 = 0.f, b1 = 0.f;
      if (!from_input) {
        g0 = p.ln_g[pln * 1024 + col0]; g1 = p.ln_g[pln * 1024 + col1];
        b0 = p.ln_b[pln * 1024 + col0]; b1 = p.ln_b[pln * 1024 + col1];
      }
#pragma unroll
      for (int mi = 0; mi < 2; ++mi)
#pragma unroll
        for (int i = 0; i < 16; ++i) {
          const int ro = mi * 32 + crow(i, 0);
          float mean = 0.f, rstd = 1.f;
          if (!from_input) {
            const f32v2 st = *(const f32v2*)(st0 + ls0 + (unsigned)(ro * 8));
            mean = st[0];
            rstd = st[1];
          }
          const unsigned o0 = lo0 + (unsigned)(ro * 4096);
          const float x0 = (*(const float*)(xb0 + o0) - mean) * rstd * g0 + b0;
          const float x1 = (*(const float*)(xb0 + o0 + 128u) - mean) * rstd * g1 + b1;
          *(float*)(ob0 + o0) = ALPHA_F * x0 + gate0 * acc[mi][0][i];
          *(float*)(ob0 + o0 + 128u) = ALPHA_F * x1 + gate1 * acc[mi][1][i];
        }
    } else if (epi == EP_SWIGLU) {
      const int j = ((n0 >> 6) + wn) * 32 + r;
      u16* act = WSP(u16, O_ACT);
      const unsigned lofs = ((unsigned)(rowb + 4 * h) * 2816u + (unsigned)j) * 2u;
#pragma unroll
      for (int mi = 0; mi < 2; ++mi)
#pragma unroll
        for (int i = 0; i < 16; ++i)
          st_u16(act, lofs + (unsigned)((mi * 32 + crow(i, 0)) * 2816 * 2), f2bf(silu_f(acc[mi][0][i]) * acc[mi][1][i]));
    } else if (epi == EP_EVEN_IN) {
      const float* cs64 = WSP(float, O_CS64);
#pragma unroll
      for (int ni = 0; ni < 2; ++ni) {
        const int cbase = colb + ni * 32;
        const int col = cbase + r;
        if (cbase < 640) {
          u16* dst0 = cbase < 512 ? WSP(u16, O_QA) : WSP(u16, O_KA);
          const int ldd = cbase < 512 ? 512 : 128;
          const unsigned lofs = ((unsigned)(rowb + 4 * h) * (unsigned)ldd + (unsigned)(cbase < 512 ? col : col - 512)) * 2u;
          const bool rowblk = (cbase & 32) == 0;
          const bool first = (r & 16) == 0;
#pragma unroll
          for (int mi = 0; mi < 2; ++mi)
#pragma unroll
            for (int i = 0; i < 16; ++i) {
              if ((i & 3) == 0) SB();
              const int R = rowb + mi * 32 + crow(i, h);
              float v = acc[mi][ni][i];
              const float pv = __shfl_xor(v, 16);
              if (lat) {
                const int tk = (R - NPR) & 1023;
                const int pos = rowblk ? (tk >> 6) : (tk & 63);
                const float cc = cs64[(pos * 16 + (r & 15)) * 2], sn = cs64[(pos * 16 + (r & 15)) * 2 + 1];
                v = first ? v * cc - pv * sn : v * cc + pv * sn;
              } else if (cbase >= 512) {
                p.out[OUT_AK + (((size_t)(R >> 8) * 2 + eo) * 256 + (R & 255)) * 128 + (col - 512)] = v;
              }
              st_u16(dst0, lofs + (unsigned)((mi * 32 + crow(i, 0)) * 2) * (unsigned)ldd, f2bf(v));
            }
        } else if (cbase < 768) {
          const int c = col - 640, kvh = c >> 6, d = c & 63;
#pragma unroll
          for (int mi = 0; mi < 2; ++mi)
#pragma unroll
            for (int g4 = 0; g4 < 4; ++g4) {
              SB();
              const int R0 = rowb + mi * 32 + 8 * g4 + 4 * h;
              u32x2 ov;
              ov[0] = pack2(acc[mi][ni][4 * g4], acc[mi][ni][4 * g4 + 1]);
              ov[1] = pack2(acc[mi][ni][4 * g4 + 2], acc[mi][ni][4 * g4 + 3]);
              if (lat) {
                const int b = (R0 - NPR) >> 10, tk = (R0 - NPR) & 1023;
                *(u32x2*)(WSP(u16, O_VTAL) + ((size_t)((eo * 8 + b) * 2 + kvh) * 64 + d) * 1536 + tk) = ov;
              } else {
                const int b = R0 >> 8, tk = R0 & 255;
                *(u32x2*)(WSP(u16, O_VTAP) + ((size_t)(b * 2 + kvh) * 64 + d) * 256 + tk) = ov;
#pragma unroll
                for (int k = 0; k < 4; ++k)
                  p.out[OUT_AV + (((size_t)b * 2 + eo) * 256 + tk + k) * 128 + c] = acc[mi][ni][4 * g4 + k];
              }
            }
        } else if (cbase < 1792 || cbase >= 2816) {
          u16* dst;
          bool do_silu = true;
          int cofs;
          if (cbase < 1280) { dst = WSP(u16, O_QB); cofs = col - 768; }
          else if (cbase < 1792) { dst = WSP(u16, O_IB); cofs = col - 1280; do_silu = false; }
          else { dst = WSP(u16, O_GB); cofs = col - 2816; }
          const unsigned lofs = ((unsigned)(rowb + 4 * h) * 512u + (unsigned)cofs) * 2u;
#pragma unroll
          for (int mi = 0; mi < 2; ++mi)
#pragma unroll
            for (int i = 0; i < 16; ++i) {
              if ((i & 3) == 0) SB();
              const int R = rowb + mi * 32 + crow(i, h);
              const float v = acc[mi][ni][i];
              st_u16(dst, lofs + (unsigned)((mi * 32 + crow(i, 0)) * 512 * 2), f2bf(do_silu ? silu_f(v) : v));
            }
        } else {
          const bool fwd = cbase < 2304;
          const int cc = col - (fwd ? 1792 : 2304);
          const float lb = WSP(float, O_LBT)[(eo * 2 + (fwd ? 0 : 1)) * 512 + cc];
          float* dst = WSP(float, fwd ? O_FF : O_FB);
          const unsigned lofs = ((unsigned)(rowb + 4 * h) * 512u + (unsigned)cc) * 4u;
#pragma unroll
          for (int mi = 0; mi < 2; ++mi)
#pragma unroll
            for (int i = 0; i < 16; ++i) {
              if ((i & 3) == 0) SB();
              const int R = rowb + mi * 32 + crow(i, h);
              st_f32(dst, lofs + (unsigned)((mi * 32 + crow(i, 0)) * 512 * 4), lb + (1.f - lb) * sigmoid_f(acc[mi][ni][i]));
            }
        }
      }
    } else if (epi == EP_ODD_IN) {
#pragma unroll
      for (int ni = 0; ni < 2; ++ni) {
        const int cbase = colb + ni * 32;
        const int col = cbase + r;
        if (cbase >= 1408 && cbase < 1664) {
          const int c = col - 1408, kvh = c >> 6, d = c & 63;
#pragma unroll
          for (int mi = 0; mi < 2; ++mi)
#pragma unroll
            for (int g4 = 0; g4 < 4; ++g4) {
              SB();
              const int R0 = rowb + mi * 32 + 8 * g4 + 4 * h;
              u32x2 ov;
              ov[0] = pack2(acc[mi][ni][4 * g4], acc[mi][ni][4 * g4 + 1]);
              ov[1] = pack2(acc[mi][ni][4 * g4 + 2], acc[mi][ni][4 * g4 + 3]);
              if (lat) {
                const int b = (R0 - NPR) >> 10, tk = (R0 - NPR) & 1023;
                *(u32x2*)(WSP(u16, O_VTDL) + ((size_t)((eo * 8 + b) * 4 + kvh) * 64 + d) * 1536 + tk) = ov;
              } else {
                const int b = R0 >> 8, tk = R0 & 255;
                *(u32x2*)(WSP(u16, O_VTDP) + ((size_t)(b * 4 + kvh) * 64 + d) * 256 + tk) = ov;
#pragma unroll
                for (int k = 0; k < 4; ++k)
                  p.out[OUT_DV + (((size_t)b * 2 + eo) * 256 + tk + k) * 256 + c] = acc[mi][ni][4 * g4 + k];
              }
            }
        } else if (cbase < 1696) {
          u16* dst = WSP(u16, O_PROJ);
          const unsigned lofs = ((unsigned)(rowb + 4 * h) * 1792u + (unsigned)col) * 2u;
#pragma unroll
          for (int mi = 0; mi < 2; ++mi)
#pragma unroll
            for (int i = 0; i < 16; ++i) {
              if ((i & 3) == 0) SB();
              const int R = rowb + mi * 32 + crow(i, h);
              st_u16(dst, lofs + (unsigned)((mi * 32 + crow(i, 0)) * 1792 * 2), f2bf(acc[mi][ni][i]));
            }
        }
      }
    } else if (epi == EP_QUP) {
      const float* cs32 = WSP(float, O_CS32);
      const float* rcq = WSP(float, O_RCQ);
#pragma unroll
      for (int ni = 0; ni < 2; ++ni) {
        const int cbase = colb + ni * 32;
        const int col = cbase + r;
        const bool ropeblk = ((cbase >> 5) % 3) == 2;
        const bool first = (r & 8) == 0;
        u16* dst = WSP(u16, O_QC);
        const unsigned lofs = ((unsigned)(rowb + 4 * h) * 768u + (unsigned)col) * 2u;
#pragma unroll
        for (int mi = 0; mi < 2; ++mi)
#pragma unroll
          for (int i = 0; i < 16; ++i) {
            if ((i & 3) == 0) SB();
            const int R = rowb + mi * 32 + crow(i, h);
            float v = acc[mi][ni][i] * rcq[R];
            const float pv = __shfl_xor(v, 8);
            if (lat && ropeblk) {
              const int tk = (R - NPR) & 1023;
              const int pos = (r < 16) ? (tk >> 6) : (tk & 63);
              const float cc = cs32[(pos * 8 + (r & 7)) * 2], sn = cs32[(pos * 8 + (r & 7)) * 2 + 1];
              v = first ? v * cc - pv * sn : v * cc + pv * sn;
            }
            st_u16(dst, lofs + (unsigned)((mi * 32 + crow(i, 0)) * 768 * 2), f2bf(v));
          }
      }
    } else {
#pragma unroll
      for (int ni = 0; ni < 2; ++ni) {
        const int cbase = colb + ni * 32;
        const int col = cbase + r;
        const int head = col >> 7, hc = col & 127;
        if ((cbase & 64) == 0) {
          u16* dst = WSP(u16, O_KN);
          const unsigned lofs = ((unsigned)(rowb + 4 * h) * 512u + (unsigned)(head * 64 + hc)) * 2u;
#pragma unroll
          for (int mi = 0; mi < 2; ++mi)
#pragma unroll
            for (int i = 0; i < 16; ++i) {
              if ((i & 3) == 0) SB();
              const int R = rowb + mi * 32 + crow(i, h);
              st_u16(dst, lofs + (unsigned)((mi * 32 + crow(i, 0)) * 512 * 2), f2bf(acc[mi][ni][i]));
            }
        } else {
          const int d = hc - 64;
#pragma unroll
          for (int mi = 0; mi < 2; ++mi)
#pragma unroll
            for (int g4 = 0; g4 < 4; ++g4) {
              SB();
              const int R0 = rowb + mi * 32 + 8 * g4 + 4 * h;
              u32x2 ov;
              ov[0] = pack2(acc[mi][ni][4 * g4], acc[mi][ni][4 * g4 + 1]);
              ov[1] = pack2(acc[mi][ni][4 * g4 + 2], acc[mi][ni][4 * g4 + 3]);
              u16* dp;
              if (R0 < NPR) dp = WSP(u16, O_VTCP) + ((size_t)((R0 >> 8) * 8 + head) * 64 + d) * 256 + (R0 & 255);
              else if (R0 < NROWS)
                dp = WSP(u16, O_VTCL) + ((size_t)(((R0 - NPR) >> 10) * 8 + head) * 64 + d) * 1536 + ((R0 - NPR) & 1023);
              else
                dp = WSP(u16, O_VTCL) + ((size_t)(((R0 - NROWS) >> 9) * 8 + head) * 64 + d) * 1536 + 1024 + ((R0 - NROWS) & 511);
              *(u32x2*)dp = ov;
            }
        }
      }
    }
  }
}

struct AttnArgs {
  const u16* Q; int ldq;
  const u16* K0; int ldk0; const u16* PE0; int kb0, ke0;
  const u16* K1; int ldk1; const u16* PE1; int ke1;
  const u16* VT; int ldvt; int vtoff1;
  int banded; int qpos0;
  int has_sink; float sink;
  float scale;
  u16* O;
};

template <int DQK>
DI void attn_item(char* smem, const AttnArgs& a) {
  constexpr int KSTR = DQK + 8;
  constexpr int VSTR = 72;
  constexpr int NKS = DQK / 16;
  constexpr int ASTAGE = 64 * KSTR + 64 * VSTR;
  u16* Ks0 = (u16*)smem;
  const int t = tid_opaque(), lane = t & 63, w = t >> 6, r = lane & 31, h = lane >> 5;
  bf16x8 qf[NKS];
  {
    const u16* qp = a.Q + (size_t)(32 * w + r) * a.ldq + 8 * h;
#pragma unroll
    for (int ks = 0; ks < NKS; ++ks) qf[ks] = *(const bf16x8*)(qp + 16 * ks);
  }
  const float sl2 = a.scale * LOG2E;
  float m = a.has_sink ? a.sink * LOG2E : -1e30f;
  float lsum = a.has_sink ? 1.f : 0.f;
  f32x16 O0 = zero16(), O1 = zero16();
  const int qp_me = a.qpos0 + 32 * w + r;
  const int n0 = (a.ke0 - a.kb0) >> 6, nt = n0 + (a.ke1 >> 6);
  u32x4 kreg[2], vreg[2], preg;
#define A_ISSUE(TI)                                                                          \
  {                                                                                          \
    const int ti_ = (TI);                                                                    \
    const bool s1_ = ti_ >= n0;                                                              \
    const u16* Kp_ = s1_ ? a.K1 : a.K0;                                                      \
    const int ldk_ = s1_ ? a.ldk1 : a.ldk0;                                                  \
    const int k0_ = s1_ ? (ti_ - n0) * 64 : a.kb0 + ti_ * 64;                                \
    const int vo_ = (s1_ ? a.vtoff1 : 0) + k0_;                                              \
    _Pragma("unroll") for (int i = 0; i < 2; ++i) {                                          \
      const int c = t + 256 * i, key = c >> 3, dc = c & 7;                                   \
      kreg[i] = *(const u32x4*)(Kp_ + (size_t)(k0_ + key) * ldk_ + dc * 8);                  \
      vreg[i] = *(const u32x4*)(a.VT + (size_t)key * a.ldvt + vo_ + dc * 8);                 \
    }                                                                                        \
    if (DQK == 96) {                                                                         \
      const u16* PEp_ = s1_ ? a.PE1 : a.PE0;                                                 \
      preg = *(const u32x4*)(PEp_ + (size_t)(k0_ + (t >> 2)) * 32 + (t & 3) * 8);            \
    }                                                                                        \
  }
  A_ISSUE(0)
  for (int ti = 0; ti < nt; ++ti) {
    {
      const bool seg1 = ti >= n0;
      const int key0 = seg1 ? (ti - n0) * 64 : a.kb0 + ti * 64;
      const bool band = a.banded && !seg1;
      u16* Ks = Ks0 + (ti & 1) * ASTAGE;
      u16* Vs = Ks + 64 * KSTR;
#pragma unroll
      for (int i = 0; i < 2; ++i) {
        const int c = t + 256 * i, key = c >> 3, dc = c & 7;
        *(u32x4*)(Ks + key * KSTR + dc * 8) = kreg[i];
        *(u32x4*)(Vs + key * VSTR + dc * 8) = vreg[i];
      }
      if (DQK == 96) *(u32x4*)(Ks + (t >> 2) * KSTR + 64 + (t & 3) * 8) = preg;
      __syncthreads();
      A_ISSUE(ti + 1 < nt ? ti + 1 : ti)
      __builtin_amdgcn_sched_barrier(0);
      f32x16 S0 = zero16(), S1 = zero16();
      __builtin_amdgcn_s_setprio(1);
#pragma unroll
      for (int ks = 0; ks < NKS; ++ks) {
        const bf16x8 k0 = *(const bf16x8*)(Ks + r * KSTR + 16 * ks + 8 * h);
        const bf16x8 k1 = *(const bf16x8*)(Ks + (32 + r) * KSTR + 16 * ks + 8 * h);
        S0 = MFMA(k0, qf[ks], S0);
        S1 = MFMA(k1, qf[ks], S1);
      }
      __builtin_amdgcn_s_setprio(0);
      float tmax = -INFINITY;
#pragma unroll
      for (int i = 0; i < 16; ++i) {
        float x0 = S0[i] * sl2, x1 = S1[i] * sl2;
        if (band) {
          const int kp0 = key0 + crow(i, h), kp1 = kp0 + 32;
          int d0 = qp_me - kp0, d1 = qp_me - kp1;
          d0 = d0 < 0 ? -d0 : d0;
          d1 = d1 < 0 ? -d1 : d1;
          if (d0 > 128) x0 = -INFINITY;
          if (d1 > 128) x1 = -INFINITY;
        }
        S0[i] = x0;
        S1[i] = x1;
        tmax = fmaxf(tmax, fmaxf(x0, x1));
      }
      tmax = xhalf_max(tmax);
      const float mnew = fmaxf(m, tmax);
      const float alpha = __builtin_amdgcn_exp2f(m - mnew);
      float rs = 0.f;
#pragma unroll
      for (int i = 0; i < 16; ++i) {
        S0[i] = __builtin_amdgcn_exp2f(S0[i] - mnew);
        S1[i] = __builtin_amdgcn_exp2f(S1[i] - mnew);
        rs += S0[i] + S1[i];
      }
      rs = xhalf_sum(rs);
      lsum = lsum * alpha + rs;
      m = mnew;
#pragma unroll
      for (int i = 0; i < 16; ++i) {
        O0[i] *= alpha;
        O1[i] *= alpha;
      }
      __builtin_amdgcn_s_setprio(1);
      const u16* v0p = Vs + r * VSTR + 4 * h;
      const u16* v1p = Vs + (32 + r) * VSTR + 4 * h;
      {
        const bf16x8 pb = pack8<0>(S0);
        O0 = MFMA(cat4(*(const s16x4*)(v0p + 0), *(const s16x4*)(v0p + 8)), pb, O0);
        O1 = MFMA(cat4(*(const s16x4*)(v1p + 0), *(const s16x4*)(v1p + 8)), pb, O1);
      }
      {
        const bf16x8 pb = pack8<1>(S0);
        O0 = MFMA(cat4(*(const s16x4*)(v0p + 16), *(const s16x4*)(v0p + 24)), pb, O0);
        O1 = MFMA(cat4(*(const s16x4*)(v1p + 16), *(const s16x4*)(v1p + 24)), pb, O1);
      }
      {
        const bf16x8 pb = pack8<0>(S1);
        O0 = MFMA(cat4(*(const s16x4*)(v0p + 32), *(const s16x4*)(v0p + 40)), pb, O0);
        O1 = MFMA(cat4(*(const s16x4*)(v1p + 32), *(const s16x4*)(v1p + 40)), pb, O1);
      }
      {
        const bf16x8 pb = pack8<1>(S1);
        O0 = MFMA(cat4(*(const s16x4*)(v0p + 48), *(const s16x4*)(v0p + 56)), pb, O0);
        O1 = MFMA(cat4(*(const s16x4*)(v1p + 48), *(const s16x4*)(v1p + 56)), pb, O1);
      }
      __builtin_amdgcn_s_setprio(0);
    }
  }
  __syncthreads();
#undef A_ISSUE
  const float inv = 1.f / lsum;
  u16* op = a.O + (size_t)(32 * w + r) * 1024 + 4 * h;
#pragma unroll
  for (int g4 = 0; g4 < 4; ++g4) {
    u32x2 o0, o1;
    o0[0] = pack2(O0[4 * g4] * inv, O0[4 * g4 + 1] * inv);
    o0[1] = pack2(O0[4 * g4 + 2] * inv, O0[4 * g4 + 3] * inv);
    o1[0] = pack2(O1[4 * g4] * inv, O1[4 * g4 + 1] * inv);
    o1[1] = pack2(O1[4 * g4 + 2] * inv, O1[4 * g4 + 3] * inv);
    *(u32x2*)(op + 8 * g4) = o0;
    *(u32x2*)(op + 32 + 8 * g4) = o1;
  }
}

DI void hgrn_item(char* smem, const P& p, int e, int item) {
  u16* Qs = (u16*)smem;
  u16* Ks = Qs + 32 * 136;
  u16* KhT = Ks + 32 * 136;
  u16* VTs = KhT + 128 * 40;
  float* dec = (float*)(VTs + 128 * 40);
  float* Tx = dec + 128;
  const int t = tid_opaque(), lane = t & 63, w = t >> 6, r = lane & 31, hh = lane >> 5;
  const bool lat = item < 64;
  int b, hd, dir;
  if (lat) { b = item >> 3; hd = (item >> 1) & 3; dir = item & 1; }
  else { const int q = item - 64; b = q >> 3; hd = (q >> 1) & 3; dir = q & 1; }
  const int L = lat ? 1024 : 256;
  const int rowbase = lat ? NPR + b * 1024 : b * 256;
  const int nchunks = L >> 5;
  const float* Fsrc = WSP(float, dir ? O_FB : O_FF) + hd * 128;
  const u16* Qsrc = WSP(u16, O_QB) + hd * 128;
  const u16* Vsrc = WSP(u16, O_IB) + hd * 128;
  float* Odst = WSP(float, O_OFB) + (size_t)dir * NROWS * 512 + hd * 128;
  f32x16 St[4];
  if (lat) {
    const float* s0 = p.state_b + ((((size_t)b * 2 + e) * 2 + dir) * 4 + hd) * 16384;
#pragma unroll
    for (int kb = 0; kb < 4; ++kb)
#pragma unroll
      for (int i = 0; i < 16; ++i) St[kb][i] = s0[(size_t)(32 * kb + crow(i, hh)) * 128 + 32 * w + r];
  } else {
#pragma unroll
    for (int kb = 0; kb < 4; ++kb) St[kb] = zero16();
  }
  const int kk = 32 * w + r, half = hh;
  float fr[16];
  unsigned qp[8], vp[8];
#pragma unroll
  for (int i = 0; i < 8; ++i) {
    const int tt = 16 * half + 2 * i;
    const int row0 = rowbase + (dir ? L - 1 - tt : tt);
    const int row1 = dir ? row0 - 1 : row0 + 1;
    fr[2 * i] = Fsrc[(size_t)row0 * 512 + kk];
    fr[2 * i + 1] = Fsrc[(size_t)row1 * 512 + kk];
    qp[i] = (unsigned)Qsrc[(size_t)row0 * 512 + kk] | ((unsigned)Qsrc[(size_t)row1 * 512 + kk] << 16);
    vp[i] = (unsigned)Vsrc[(size_t)row0 * 512 + kk] | ((unsigned)Vsrc[(size_t)row1 * 512 + kk] << 16);
  }
  for (int n = 0; n < nchunks; ++n) {
    float cl[16];
    {
      float c = 0.f;
#pragma unroll
      for (int i = 0; i < 16; ++i) {
        c += __logf(fmaxf(fr[i], 1e-30f));
        cl[i] = c;
      }
      cl[15] = c;
    }
    {
      float T0, T1;
      {
        auto rr2 = __builtin_amdgcn_permlane32_swap(__float_as_uint(cl[15]), __float_as_uint(cl[15]), false, false);
        T0 = __uint_as_float(rr2[0]);
        T1 = __uint_as_float(rr2[1]);
      }
      const float last = T0 + T1, off = half ? T0 : 0.f;
      float khv[16];
#pragma unroll
      for (int i = 0; i < 16; ++i) {
        const float cum = cl[i] + off;
        const int s = 16 * half + i;
        const float kvv = 1.f - fr[i];
        const float qv = __uint_as_float((i & 1) ? (qp[i >> 1] & 0xffff0000u) : (qp[i >> 1] << 16));
        Qs[s * 136 + kk] = f2bf(qv * 0.08838834764831845f * __expf(cum));
        Ks[s * 136 + kk] = f2bf(kvv * __expf(fminf(-cum, 80.f)));
        khv[i] = kvv * __expf(last - cum);
      }
      u32x4 k0, k1, v0, v1;
#pragma unroll
      for (int q = 0; q < 4; ++q) {
        k0[q] = pack2(khv[2 * q], khv[2 * q + 1]);
        k1[q] = pack2(khv[8 + 2 * q], khv[8 + 2 * q + 1]);
        v0[q] = vp[q];
        v1[q] = vp[4 + q];
      }
      *(u32x4*)(KhT + kk * 40 + 16 * half) = k0;
      *(u32x4*)(KhT + kk * 40 + 16 * half + 8) = k1;
      *(u32x4*)(VTs + kk * 40 + 16 * half) = v0;
      *(u32x4*)(VTs + kk * 40 + 16 * half + 8) = v1;
      if (half == 0) dec[kk] = __expf(last);
    }
    if (n + 1 < nchunks) {
#pragma unroll
      for (int i = 0; i < 8; ++i) {
        const int tt = (n + 1) * 32 + 16 * half + 2 * i;
        const int row0 = rowbase + (dir ? L - 1 - tt : tt);
        const int row1 = dir ? row0 - 1 : row0 + 1;
        fr[2 * i] = Fsrc[(size_t)row0 * 512 + kk];
        fr[2 * i + 1] = Fsrc[(size_t)row1 * 512 + kk];
        qp[i] = (unsigned)Qsrc[(size_t)row0 * 512 + kk] | ((unsigned)Qsrc[(size_t)row1 * 512 + kk] << 16);
        vp[i] = (unsigned)Vsrc[(size_t)row0 * 512 + kk] | ((unsigned)Vsrc[(size_t)row1 * 512 + kk] << 16);
      }
    }
    __syncthreads();
    __builtin_amdgcn_s_setprio(1);
    f32x16 oacc = zero16();
#pragma unroll
    for (int kb = 0; kb < 4; ++kb) {
      const u16* qp = Qs + r * 136 + 32 * kb + 4 * hh;
      oacc = MFMA(pack8<0>(St[kb]), cat4(*(const s16x4*)(qp), *(const s16x4*)(qp + 8)), oacc);
      oacc = MFMA(pack8<1>(St[kb]), cat4(*(const s16x4*)(qp + 16), *(const s16x4*)(qp + 24)), oacc);
    }
    {
      f32x16 at = zero16();
#pragma unroll
      for (int ks = 0; ks < 8; ++ks) {
        const bf16x8 ka = *(const bf16x8*)(Ks + r * 136 + 16 * ks + 8 * hh);
        const bf16x8 qb = *(const bf16x8*)(Qs + r * 136 + 16 * ks + 8 * hh);
        at = MFMA(ka, qb, at);
      }
#pragma unroll
      for (int i = 0; i < 16; ++i)
        if (crow(i, hh) > r) at[i] = 0.f;
      const u16* vp = VTs + (32 * w + r) * 40 + 4 * hh;
      oacc = MFMA(cat4(*(const s16x4*)(vp), *(const s16x4*)(vp + 8)), pack8<0>(at), oacc);
      oacc = MFMA(cat4(*(const s16x4*)(vp + 16), *(const s16x4*)(vp + 24)), pack8<1>(at), oacc);
    }
#pragma unroll
    for (int kb = 0; kb < 4; ++kb) {
#pragma unroll
      for (int g4 = 0; g4 < 4; ++g4) {
        const f32x4 dv = *(const f32x4*)(dec + 32 * kb + 8 * g4 + 4 * hh);
#pragma unroll
        for (int k = 0; k < 4; ++k) St[kb][4 * g4 + k] *= dv[k];
      }
#pragma unroll
      for (int ks = 0; ks < 2; ++ks) {
        const bf16x8 ka = *(const bf16x8*)(KhT + (32 * kb + r) * 40 + 16 * ks + 8 * hh);
        const bf16x8 vb = *(const bf16x8*)(VTs + (32 * w + r) * 40 + 16 * ks + 8 * hh);
        St[kb] = MFMA(ka, vb, St[kb]);
      }
    }
    __builtin_amdgcn_s_setprio(0);
    {
      const int tt = n * 32 + r;
      const int row = rowbase + (dir ? L - 1 - tt : tt);
      float* od = Odst + (size_t)row * 512 + 32 * w + 4 * hh;
#pragma unroll
      for (int g4 = 0; g4 < 4; ++g4) {
        f32x4 v;
#pragma unroll
        for (int k = 0; k < 4; ++k) v[k] = oacc[4 * g4 + k];
        *(f32x4*)(od + 8 * g4) = v;
      }
    }
    __syncthreads();
  }
  if (!lat) {
    float* sd = p.out + OUT_SB + ((((size_t)b * 2 + e) * 2 + dir) * 4 + hd) * 16384;
#pragma unroll
    for (int kb = 0; kb < 4; ++kb)
#pragma unroll
      for (int i = 0; i < 16; ++i) sd[(size_t)(32 * kb + crow(i, hh)) * 128 + 32 * w + r] = St[kb][i];
  }
}

DI int queue_next(char* smem, unsigned* ctr) {
  int* slot = (int*)(smem + 73728 - 16);
  if (tid_opaque() == 0) *slot = (int)atomicAdd(ctr, 1u);
  __syncthreads();
  const int item = *slot;
  __syncthreads();
  return item;
}

DI void mixer_even_phase(const P& p, char* smem, int e) {
  unsigned* ctr = (unsigned*)(p.ws + O_BAR) + 3600 + 64 * e;
  for (;;) {
    const int qi = queue_next(smem, ctr);
    if (qi >= 320 + 1024) {
      const int ndef = (e == 0 ? NDEF0 : NDEF1);
      int dq = qi - (320 + 1024);
      if (dq >= ndef) break;
      float* smf = (float*)smem;
      int ta = deferred_task(e, dq), tb = 0;
      float va[32], vb[32];
      transpose_load(tdesc(p, ta), va);
      for (;;) {
        dq = queue_next(smem, ctr) - (320 + 1024);
        const bool hb = dq < ndef;
        tb = deferred_task(e, hb ? dq : 0);
        transpose_load(tdesc(p, tb), vb);
        transpose_finish(smf, tdesc(p, ta), va);
        if (!hb) break;
        dq = queue_next(smem, ctr) - (320 + 1024);
        const bool ha = dq < ndef;
        ta = deferred_task(e, ha ? dq : 0);
        transpose_load(tdesc(p, ta), va);
        transpose_finish(smf, tdesc(p, tb), vb);
        if (!ha) break;
      }
      break;
    }
    int item;
    if (qi < 64) item = qi;
    else if (qi < 576) item = 320 + (qi - 64);
    else if (qi < 832) item = 64 + (qi - 576);
    else item = 320 + 512 + (qi - 832);
    if (item < 320) {
      hgrn_item(smem, p, e, item);
    } else {
      AttnArgs a;
      const int q = item - 320;
      a.ldq = 512; a.PE0 = nullptr; a.PE1 = nullptr; a.ldk0 = 128; a.ldk1 = 128; a.has_sink = 1; a.scale = 0.125f;
      if (q < 512) {
        const int b = q >> 6, head = (q >> 3) & 7, qt = q & 7, kvh = head >> 2;
        const int row0 = NPR + b * 1024;
        a.Q = WSP(u16, O_QA) + (size_t)(row0 + qt * 128) * 512 + head * 64;
        a.K0 = WSP(u16, O_KA) + (size_t)row0 * 128 + kvh * 64;
        a.kb0 = qt * 128 - 128 < 0 ? 0 : qt * 128 - 128;
        a.ke0 = qt * 128 + 256 > 1024 ? 1024 : qt * 128 + 256;
        a.K1 = WSP(u16, O_KCA) + (size_t)((e * 8 + b) * 512) * 128 + kvh * 64;
        a.ke1 = 512;
        a.VT = WSP(u16, O_VTAL) + (size_t)(((e * 8 + b) * 2 + kvh) * 64) * 1536;
        a.ldvt = 1536; a.vtoff1 = 1024; a.banded = 1; a.qpos0 = qt * 128;
        a.sink = p.a_sink[e * 8 + head];
        a.O = WSP(u16, O_HM) + (size_t)(row0 + qt * 128) * 1024 + head * 64;
      } else {
        const int q2 = q - 512;
        const int b = q2 >> 4, head = (q2 >> 1) & 7, qt = q2 & 1, kvh = head >> 2;
        const int row0 = b * 256;
        a.Q = WSP(u16, O_QA) + (size_t)(row0 + qt * 128) * 512 + head * 64;
        a.K0 = WSP(u16, O_KA) + (size_t)row0 * 128 + kvh * 64;
        a.kb0 = 0; a.ke0 = 256;
        a.K1 = a.K0; a.ke1 = 0;
        a.VT = WSP(u16, O_VTAP) + (size_t)((b * 2 + kvh) * 64) * 256;
        a.ldvt = 256; a.vtoff1 = 0; a.banded = 0; a.qpos0 = 0;
        a.sink = p.a_sink[e * 8 + head];
        a.O = WSP(u16, O_HM) + (size_t)(row0 + qt * 128) * 1024 + head * 64;
      }
      attn_item<64>(smem, a);
    }
  }
}

DI void mixer_odd_phase(const P& p, char* smem, int o) {
  unsigned* ctr = (unsigned*)(p.ws + O_BAR) + 3600 + 64 * (2 + o);
  for (;;) {
    const int item = queue_next(smem, ctr);
    if (item >= 2048) break;
    AttnArgs a;
    a.has_sink = 0; a.sink = 0.f; a.banded = 0; a.qpos0 = 0; a.kb0 = 0;
    const int grp = item >> 9, q = item & 511;
    const bool lat = grp < 2, isC = (grp & 1) == 0;
    int b, head, qt, row0, nk;
    if (lat) { b = q >> 6; head = (q >> 3) & 7; qt = q & 7; row0 = NPR + b * 1024; nk = 1024; }
    else { b = q >> 4; head = (q >> 1) & 7; qt = q & 1; row0 = b * 256; nk = 256; }
    a.ke0 = nk;
    a.ke1 = lat ? 512 : 0;
    a.ldvt = lat ? 1536 : 256;
    a.vtoff1 = 1024;
    if (isC) {
      a.Q = WSP(u16, O_QC) + (size_t)(row0 + qt * 128) * 768 + head * 96; a.ldq = 768;
      a.K0 = WSP(u16, O_KN) + (size_t)row0 * 512 + head * 64; a.ldk0 = 512;
      a.PE0 = WSP(u16, O_KPE) + (size_t)row0 * 32;
      a.K1 = WSP(u16, O_KN) + (size_t)(NROWS + b * 512) * 512 + head * 64; a.ldk1 = 512;
      a.PE1 = WSP(u16, O_PECTX) + (size_t)((o * 8 + b) * 512) * 32;
      a.VT = lat ? WSP(u16, O_VTCL) + (size_t)((b * 8 + head) * 64) * 1536
                 : WSP(u16, O_VTCP) + (size_t)((b * 8 + head) * 64) * 256;
      a.scale = 0.10206207261596575f;
      a.O = WSP(u16, O_HM) + (size_t)(row0 + qt * 128) * 1024 + head * 64;
      attn_item<96>(smem, a);
    } else {
      const int kvh = head >> 1;
      a.Q = WSP(u16, O_QD) + (size_t)(row0 + qt * 128) * 512 + head * 64; a.ldq = 512;
      a.K0 = WSP(u16, O_KD) + (size_t)row0 * 256 + kvh * 64; a.ldk0 = 256;
      a.PE0 = nullptr; a.PE1 = nullptr;
      a.K1 = WSP(u16, O_KCD) + (size_t)((o * 8 + b) * 512) * 256 + kvh * 64; a.ldk1 = 256;
      a.VT = lat ? WSP(u16, O_VTDL) + (size_t)(((o * 8 + b) * 4 + kvh) * 64) * 1536
                 : WSP(u16, O_VTDP) + (size_t)((b * 4 + kvh) * 64) * 256;
      a.scale = 0.125f;
      a.O = WSP(u16, O_HM) + (size_t)(row0 + qt * 128) * 1024 + 512 + head * 64;
      attn_item<64>(smem, a);
    }
  }
}


#define XB_TMO      128
#define XB_XCNT(j)  (256  + 64 * (j))
#define XB_XSUB(j)  (1280 + 64 * (j))
#define XB_XGEN(j)  (2304 + 64 * (j))
#define XB_TOP      3328
#define XB_TOPGEN   3392
#define XCD_BAR_WORDS 3456
#define XB_SPIN_CAP (1u << 20)
#define LAS __attribute__((address_space(3)))
DI unsigned xb_ld(unsigned* q) { return __hip_atomic_load(q, __ATOMIC_RELAXED, __HIP_MEMORY_SCOPE_AGENT); }
DI unsigned xb_add(unsigned* q, unsigned v) { return __hip_atomic_fetch_add(q, v, __ATOMIC_RELAXED, __HIP_MEMORY_SCOPE_AGENT); }
DI unsigned xb_xcc_id() { return (unsigned)__builtin_amdgcn_s_getreg((3 << 11) | 20) & 0xFu; }
#define XB_SPIN(cond, bar) do { unsigned _sp = 0; while (cond) { __builtin_amdgcn_s_sleep(1); \
    if ((++_sp & 255u) == 0u) { if (xb_ld(&(bar)[XB_TMO])) break; if (_sp > XB_SPIN_CAP) { atomicAdd(&(bar)[XB_TMO], 1u); break; } } } } while (0)
struct XcdBarrier { unsigned* bar; unsigned x; volatile LAS unsigned* st; };
DI XcdBarrier xcd_barrier_post(unsigned* bar, volatile LAS unsigned* st) {
  XcdBarrier b; b.bar = bar; b.x = xb_xcc_id(); b.st = st;
  if (threadIdx.x == 0) (void)xb_add(&bar[XB_XCNT(b.x)], 1u);
  return b;
}
DI void xcd_barrier_complete(unsigned* bar, unsigned x, unsigned& nloc, unsigned& nx) {
  const unsigned G = gridDim.x * gridDim.y * gridDim.z;
  unsigned sum, cnt, mine, sp = 0u;
  for (;;) {
    sum = 0u; cnt = 0u; mine = 0u;
#pragma unroll
    for (unsigned j = 0; j < 16; ++j) { const unsigned c = xb_ld(&bar[XB_XCNT(j)]); sum += c; cnt += (c > 0u) ? 1u : 0u; mine = (j == x) ? c : mine; }
    if (sum == G) break;
    __builtin_amdgcn_s_sleep(1);
    if ((++sp & 255u) == 0u) { if (xb_ld(&bar[XB_TMO])) break; if (sp > XB_SPIN_CAP) { atomicAdd(&bar[XB_TMO], 1u); break; } }
  }
  nloc = mine > 0u ? mine : 1u; nx = cnt > 0u ? cnt : 1u;
}
DI void xcd_barrier(const XcdBarrier& b) {
  asm volatile("s_waitcnt vmcnt(0)" ::: "memory");
  __syncthreads();
  if (threadIdx.x == 0) {
    unsigned* bar = b.bar;
    __builtin_amdgcn_s_waitcnt(0);
    unsigned nloc = b.st[0], nx = b.st[1];
    if (nloc == 0u) { xcd_barrier_complete(bar, b.x, nloc, nx); b.st[0] = nloc; b.st[1] = nx; }
    const unsigned old = xb_add(&bar[XB_XSUB(b.x)], 1u);
    const unsigned gen = old / nloc;
    if (old + 1u == (gen + 1u) * nloc) {
      __builtin_amdgcn_fence(__ATOMIC_RELEASE, "agent");
      asm volatile("s_waitcnt vmcnt(0)" ::: "memory");
      const unsigned og = xb_add(&bar[XB_TOP], 1u);
      const unsigned tg = og / nx;
      if (og + 1u == (tg + 1u) * nx) xb_add(&bar[XB_TOPGEN], 1u);
      else XB_SPIN(xb_ld(&bar[XB_TOPGEN]) == tg, bar);
      __builtin_amdgcn_fence(__ATOMIC_ACQUIRE, "agent");
      xb_add(&bar[XB_XGEN(b.x)], 1u);
      asm volatile("s_waitcnt vmcnt(0)" ::: "memory");
    } else {
      XB_SPIN(xb_ld(&bar[XB_XGEN(b.x)]) == gen, bar);
      __builtin_amdgcn_fence(__ATOMIC_ACQUIRE, "agent");
      asm volatile("s_waitcnt vmcnt(0)" ::: "memory");
    }
  }
  __syncthreads();
}

constexpr int N_PHASES = 2 + 2 * 17;

__global__ void __launch_bounds__(256, 2) mega(P p, int ph_lo, int ph_hi) {
  __shared__ __attribute__((aligned(16))) char smem[73728];
  cg::grid_group grid = cg::this_grid();
  __shared__ uint4 xb_words;
  if (threadIdx.x == 0) xb_words = make_uint4(0u, 0u, 0u, 0u);
  __syncthreads();
  XcdBarrier xb = xcd_barrier_post((unsigned*)(p.ws + O_BAR), (volatile LAS unsigned*)&xb_words);
  for (int ph = ph_lo; ph < ph_hi; ++ph) {
    if (ph == 0) prep_phase(p, smem);
    else if (ph == 1) h0_phase(p);
    else {
      const int q = ph - 2, pair = q / 17, rr = q % 17;
      int l, idx;
      if (rr < 8) {
        l = 2 * pair;
        const int map[8] = {0, 3, 4, 5, 6, 7, 8, 9};
        idx = rr == 0 ? 0 : rr + 2;
        (void)map;
      } else {
        l = 2 * pair + 1;
        const int r2 = rr - 8;
        idx = r2 < 4 ? r2 : r2 + 1;
      }
      const bool even = (l & 1) == 0;
#ifdef DUPMASK
      if ((DUPMASK >> idx) & 1) {
        if (idx == 0) gemm_phase(p, smem, even ? G_EVEN_IN : G_ODD_IN, l);
        else if (idx == 2) gemm_phase(p, smem, G_UPS, l);
        else if (idx == 3) { if (even) mixer_even_phase(p, smem, l >> 1); else mixer_odd_phase(p, smem, l >> 1); }
        else if (idx == 7) gemm_phase(p, smem, G_FFNUP, l);
        xcd_barrier(xb);
      }
#endif
      if (idx == 0) gemm_phase(p, smem, even ? G_EVEN_IN : G_ODD_IN, l);
      else if (idx == 1) post_odd_phase(p, l >> 1);
      else if (idx == 2) gemm_phase(p, smem, G_UPS, l);
      else if (idx == 3) { if (even) mixer_even_phase(p, smem, l >> 1); else mixer_odd_phase(p, smem, l >> 1); }
      else if (idx == 4) hfin_phase(p, l >> 1);
      else if (idx == 5) gemm_phase(p, smem, G_OUTP, l);
      else if (idx == 6) ln_phase(p, l, 0);
      else if (idx == 7) gemm_phase(p, smem, G_FFNUP, l);
      else if (idx == 8) gemm_phase(p, smem, G_FFNDN, l);
      else ln_phase(p, l, 1);
    }
    if (ph + 1 < ph_hi) { if (ph == ph_lo) grid.sync(); else xcd_barrier(xb); }
  }
}

extern "C" void kernel_launch(void* const* d_in, const int* in_sizes, int n_in, void* d_out, int out_size, void* d_ws,
                              size_t ws_size, hipStream_t stream) {
  static int grid_blocks = 0;
  if (!grid_blocks) {
    int dev = 0, cus = 0, per_cu = 0;
    hipGetDevice(&dev);
    hipDeviceGetAttribute(&cus, hipDeviceAttributeMultiprocessorCount, dev);
    hipOccupancyMaxActiveBlocksPerMultiprocessor(&per_cu, mega, 256, 0);
    if (per_cu > 2) per_cu = 2;
    if (per_cu < 1) per_cu = 1;
    grid_blocks = (cus * per_cu) & ~7;
  }
  P p{};
  const float** pp = (const float**)&p;
  for (int i = 0; i < 30; ++i) pp[i] = (const float*)d_in[i];
  p.out = (float*)d_out;
  p.ws = (char*)d_ws;
  hipMemsetAsync((char*)d_ws + O_BAR, 0, 16384, stream);
  hipMemsetAsync((char*)d_ws + O_MOD, 0, SZ_MOD, stream);
  int lo = 0, hi = N_PHASES;
  void* args[] = {&p, &lo, &hi};
  hipError_t e = hipLaunchCooperativeKernel((void*)mega, dim3(grid_blocks), dim3(256), args, 0, stream);
  if (e != hipSuccess) fprintf(stderr, "cooperative launch failed: %s (grid %d)\n", hipGetErrorString(e), grid_blocks);
}
```

```cpp
#include <hip/hip_runtime.h>
#include <hip/hip_cooperative_groups.h>
#include <cstdio>
namespace cg = cooperative_groups;

typedef unsigned short u16;
typedef short bf16x8 __attribute__((ext_vector_type(8)));
typedef short s16x4 __attribute__((ext_vector_type(4)));
typedef float f32x16 __attribute__((ext_vector_type(16)));
typedef float f32x4 __attribute__((ext_vector_type(4)));
typedef unsigned u32x4 __attribute__((ext_vector_type(4)));
typedef unsigned u32x2 __attribute__((ext_vector_type(2)));

#define DI __device__ __forceinline__
#define SB()
#define MFMA(a, b, c) __builtin_amdgcn_mfma_f32_32x32x16_bf16((a), (b), (c), 0, 0, 0)

constexpr int NROWS = 16384;
constexpr int NPR = 8192;
constexpr float ALPHA_F = 1.681792830507429f;
constexpr float LOG2E = 1.4426950408889634f;

constexpr size_t OUT_AK = 16777216, OUT_AV = 18874368, OUT_SB = 20971520, OUT_CKV = 29360128,
                 OUT_CPE = 33554432, OUT_DK = 34078720, OUT_DV = 38273024;

constexpr size_t SZ_WAB = 2ull * 3328 * 1024 * 2, SZ_WCD = 2ull * 1792 * 1024 * 2, SZ_WQU = 2ull * 768 * 384 * 2,
                 SZ_WKVU = 2ull * 1024 * 256 * 2, SZ_WO = 4ull * 1024 * 1024 * 2, SZ_WGU = 4ull * 5632 * 1024 * 2,
                 SZ_WD = 4ull * 1024 * 2816 * 2;
constexpr size_t O_WAB = 0, O_WCD = O_WAB + SZ_WAB, O_WQU = O_WCD + SZ_WCD, O_WKVU = O_WQU + SZ_WQU,
                 O_WO = O_WKVU + SZ_WKVU, O_WGU = O_WO + SZ_WO, O_WD = O_WGU + SZ_WGU, O_MOD = O_WD + SZ_WD;
constexpr size_t SZ_MOD = 4ull * 9 * 6144 * 4;
constexpr size_t O_CS64 = O_MOD + SZ_MOD;
constexpr size_t O_CS32 = O_CS64 + 64 * 16 * 2 * 4;
constexpr size_t O_LBT = O_CS32 + 64 * 8 * 2 * 4;
constexpr size_t O_HM = O_LBT + 2 * 2 * 512 * 4;
constexpr size_t O_R1 = O_HM + 16384ull * 1024 * 2;
constexpr size_t O_QA = O_R1, O_KA = O_QA + 16384ull * 512 * 2, O_QB = O_KA + 16384ull * 128 * 2,
                 O_IB = O_QB + 16384ull * 512 * 2, O_GB = O_IB + 16384ull * 512 * 2, O_FF = O_GB + 16384ull * 512 * 2,
                 O_FB = O_FF + 16384ull * 512 * 4, O_R1E_END = O_FB + 16384ull * 512 * 4;
constexpr size_t O_PROJ = O_R1, O_CKVN = O_PROJ + 16384ull * 1792 * 2, O_KPE = O_CKVN + 20480ull * 256 * 2,
                 O_QD = O_KPE + 16384ull * 32 * 2, O_KD = O_QD + 16384ull * 512 * 2, O_QC = O_KD + 16384ull * 256 * 2,
                 O_KN = O_QC + 16384ull * 768 * 2, O_RCQ = O_KN + 20480ull * 512 * 2, O_R1O_END = O_RCQ + 16384 * 4;
constexpr size_t O_ACT = O_R1;
constexpr size_t SZ_R1 = (O_R1O_END > O_R1E_END ? O_R1O_END : O_R1E_END) - O_R1;
constexpr size_t O_OFB = O_R1 + SZ_R1;
constexpr size_t O_VTAP = O_OFB + 2ull * 16384 * 512 * 4;
constexpr size_t O_VTAL = O_VTAP + 32ull * 2 * 64 * 256 * 2;
constexpr size_t O_KCA = O_VTAL + 2ull * 8 * 2 * 64 * 1536 * 2;
constexpr size_t O_VTDP = O_KCA + 2ull * 8 * 512 * 128 * 2;
constexpr size_t O_VTDL = O_VTDP + 32ull * 4 * 64 * 256 * 2;
constexpr size_t O_KCD = O_VTDL + 2ull * 8 * 4 * 64 * 1536 * 2;
constexpr size_t O_VTCP = O_KCD + 2ull * 8 * 512 * 256 * 2;
constexpr size_t O_VTCL = O_VTCP + 32ull * 8 * 64 * 256 * 2;
constexpr size_t O_PECTX = O_VTCL + 8ull * 8 * 64 * 1536 * 2;
constexpr size_t WS_TOTAL = O_PECTX + 2ull * 8 * 512 * 32 * 2;
constexpr size_t O_BAR = (WS_TOTAL + 255) & ~(size_t)255;
constexpr size_t O_ST = O_BAR + 16384;
static_assert(O_ST + 16384 * 8 < 411000000ull, "workspace too large");
static_assert(16384ull * 2816 * 2 <= SZ_R1, "ACT must fit R1");

struct P {
  const float *x_prompt, *x_sample, *cache_a_k, *cache_a_v, *state_b, *cache_c_kv, *cache_c_pe, *cache_d_k, *cache_d_v,
      *c, *c_ctx, *w_ada, *b_ada, *ln_g, *ln_b, *w_in_ab, *a_sink, *b_lb, *b_gnorm, *w_in_cd, *c_q_norm, *c_kv_norm,
      *c_w_q_up, *c_w_kv_up, *d_q_norm, *d_k_norm, *w_out, *w_ffn_gate, *w_ffn_up, *w_ffn_down;
  float* out;
  char* ws;
};

DI float bf2f(u16 v) { return __uint_as_float(((unsigned)v) << 16); }
typedef __bf16 bf16v2 __attribute__((ext_vector_type(2)));
typedef float f32v2 __attribute__((ext_vector_type(2)));
DI unsigned pack2(float a, float b) {
  f32v2 v;
  v[0] = a;
  v[1] = b;
  return __builtin_bit_cast(unsigned, __builtin_convertvector(v, bf16v2));
}
DI u16 f2bf(float x) { return (u16)(pack2(x, x) & 0xffffu); }
DI int crow(int i, int h) { return (i & 3) + 8 * (i >> 2) + 4 * h; }
DI float silu_f(float x) { return x * __builtin_amdgcn_rcpf(1.f + __expf(-x)); }
DI float sigmoid_f(float x) { return __builtin_amdgcn_rcpf(1.f + __expf(-x)); }
DI int mod_index(int R) { return R < NPR ? 0 : 1 + ((R - NPR) >> 10); }
DI float xhalf_max(float x) {
  auto r = __builtin_amdgcn_permlane32_swap(__float_as_uint(x), __float_as_uint(x), false, false);
  return fmaxf(__uint_as_float(r[0]), __uint_as_float(r[1]));
}
DI float xhalf_sum(float x) {
  auto r = __builtin_amdgcn_permlane32_swap(__float_as_uint(x), __float_as_uint(x), false, false);
  return __uint_as_float(r[0]) + __uint_as_float(r[1]);
}
DI float wave_sum(float v) {
#pragma unroll
  for (int o = 32; o >= 1; o >>= 1) v += __shfl_xor(v, o);
  return v;
}
template <int S>
DI bf16x8 pack8(const f32x16& x) {
  u32x4 p;
  p[0] = pack2(x[8 * S + 0], x[8 * S + 1]);
  p[1] = pack2(x[8 * S + 2], x[8 * S + 3]);
  p[2] = pack2(x[8 * S + 4], x[8 * S + 5]);
  p[3] = pack2(x[8 * S + 6], x[8 * S + 7]);
  return __builtin_bit_cast(bf16x8, p);
}
DI bf16x8 cat4(s16x4 lo, s16x4 hi) { return __builtin_shufflevector(lo, hi, 0, 1, 2, 3, 4, 5, 6, 7); }
DI f32x16 zero16() {
  f32x16 z;
#pragma unroll
  for (int i = 0; i < 16; ++i) z[i] = 0.f;
  return z;
}

DI int tid_opaque() { int x = threadIdx.x; asm volatile("" : "+v"(x)); return x; }
DI int bid_opaque() { int x = blockIdx.x; asm volatile("" : "+s"(x)); return x; }
DI void st_u16(void* base, unsigned boff, u16 v) { *(u16*)((char*)base + boff) = v; }
DI void st_f32(void* base, unsigned boff, float v) { *(float*)((char*)base + boff) = v; }
#define WSP(T, off) ((T*)(p.ws + (off)))

struct TDesc { const float* g0; const float* g1; const float* kscale; u16* dst; int ld_src, kind, k0, n0, ld_dst, pad_; };

DI void transpose_load(const TDesc d, float (&v)[32]) {
  const int t = tid_opaque();
  const int n = t & 127, kh = t >> 7;
  const int nd = d.n0 + n;
  const float* src = nullptr;
  if (d.kind == 0) src = d.g0 + nd;
  else if (d.kind == 1) {
    if (nd < 640) src = d.g0 + nd;
    else if (nd < 1664) src = d.g0 + nd + 32;
    else if (nd < 1696) src = d.g0 + nd - 1024;
  } else {
    const int which = (nd >> 5) & 1, j = (nd >> 6) * 32 + (nd & 31);
    src = (which ? d.g1 : d.g0) + j;
  }
#pragma unroll
  for (int i = 0; i < 32; ++i) v[i] = src ? __builtin_nontemporal_load(src + (size_t)(d.k0 + kh + 2 * i) * d.ld_src) : 0.f;
}
DI void transpose_finish(float* sm, const TDesc d, const float (&v)[32]) {
  const int t = tid_opaque();
  {
    const int n = t & 127, kh = t >> 7;
#pragma unroll
    for (int i = 0; i < 32; ++i) {
      const int k = kh + 2 * i;
      sm[k * 129 + n] = d.kscale ? v[i] * d.kscale[d.k0 + k] : v[i];
    }
  }
  __syncthreads();
#pragma unroll
  for (int j = 0; j < 4; ++j) {
    const int c = t + 256 * j, n = c >> 3, kc = c & 7;
    u32x4 o;
#pragma unroll
    for (int q = 0; q < 4; ++q) o[q] = pack2(sm[(kc * 8 + 2 * q) * 129 + n], sm[(kc * 8 + 2 * q + 1) * 129 + n]);
    *(u32x4*)(d.dst + (size_t)(d.n0 + n) * d.ld_dst + d.k0 + kc * 8) = o;
  }
  __syncthreads();
}

constexpr int T_AB = 416, T_CD = 224, T_QU = 36, T_KVU = 32, T_O = 128, T_GU = 704, T_D = 352;
constexpr int E_AB = 2 * T_AB, E_CD = E_AB + 2 * T_CD, E_QU = E_CD + 2 * T_QU, E_KVU = E_QU + 2 * T_KVU,
              E_O = E_KVU + 4 * T_O, E_GU = E_O + 4 * T_GU, E_D = E_GU + 4 * T_D;

DI TDesc tdesc(const P& p, int task) {
  TDesc d;
  d.g1 = nullptr; d.kscale = nullptr; d.kind = 0; d.pad_ = 0;
  if (task < E_AB) {
    const int e = task / T_AB, r = task % T_AB, kt = r / 26, nt = r % 26;
    d.g0 = p.w_in_ab + (size_t)e * 1024 * 3328; d.ld_src = 3328; d.k0 = kt * 64; d.n0 = nt * 128;
    d.dst = WSP(u16, O_WAB) + (size_t)e * 3328 * 1024; d.ld_dst = 1024;
  } else if (task < E_CD) {
    const int q = task - E_AB, o = q / T_CD, r = q % T_CD, kt = r / 14, nt = r % 14;
    d.g0 = p.w_in_cd + (size_t)o * 1024 * 1696; d.ld_src = 1696; d.kind = 1; d.k0 = kt * 64; d.n0 = nt * 128;
    d.dst = WSP(u16, O_WCD) + (size_t)o * 1792 * 1024; d.ld_dst = 1024;
  } else if (task < E_QU) {
    const int q = task - E_CD, o = q / T_QU, r = q % T_QU, kt = r / 6, nt = r % 6;
    d.g0 = p.c_w_q_up + (size_t)o * 384 * 768; d.ld_src = 768; d.k0 = kt * 64; d.n0 = nt * 128;
    d.dst = WSP(u16, O_WQU) + (size_t)o * 768 * 384; d.ld_dst = 384; d.kscale = p.c_q_norm + o * 384;
  } else if (task < E_KVU) {
    const int q = task - E_QU, o = q / T_KVU, r = q % T_KVU, kt = r / 8, nt = r % 8;
    d.g0 = p.c_w_kv_up + (size_t)o * 256 * 1024; d.ld_src = 1024; d.k0 = kt * 64; d.n0 = nt * 128;
    d.dst = WSP(u16, O_WKVU) + (size_t)o * 1024 * 256; d.ld_dst = 256;
  } else if (task < E_O) {
    const int q = task - E_KVU, l = q / T_O, r = q % T_O, kt = r / 8, nt = r % 8;
    d.g0 = p.w_out + (size_t)l * 1024 * 1024; d.ld_src = 1024; d.k0 = kt * 64; d.n0 = nt * 128;
    d.dst = WSP(u16, O_WO) + (size_t)l * 1024 * 1024; d.ld_dst = 1024;
  } else if (task < E_GU) {
    const int q = task - E_O, l = q / T_GU, r = q % T_GU, kt = r / 44, nt = r % 44;
    d.g0 = p.w_ffn_gate + (size_t)l * 1024 * 2816; d.g1 = p.w_ffn_up + (size_t)l * 1024 * 2816; d.ld_src = 2816; d.kind = 2;
    d.k0 = kt * 64; d.n0 = nt * 128; d.dst = WSP(u16, O_WGU) + (size_t)l * 5632 * 1024; d.ld_dst = 1024;
  } else {
    const int q = task - E_GU, l = q / T_D, r = q % T_D, kt = r / 8, nt = r % 8;
    d.g0 = p.w_ffn_down + (size_t)l * 2816 * 1024; d.ld_src = 1024; d.k0 = kt * 64; d.n0 = nt * 128;
    d.dst = WSP(u16, O_WD) + (size_t)l * 1024 * 2816; d.ld_dst = 2816;
  }
  return d;
}
DI void transpose_task(const P& p, float* sm, int task) {
  const TDesc d = tdesc(p, task);
  float v[32];
  transpose_load(d, v);
  transpose_finish(sm, d, v);
}

constexpr int NDEF0 = 2 * (T_O + T_GU + T_D) + T_CD + T_QU + T_KVU + T_AB, NDEF1 = NDEF0 - T_AB;
DI int deferred_task(int e, int q) {
  const int l0 = 2 * e;
  if (q < T_O) return E_KVU + l0 * T_O + q;
  q -= T_O;
  if (q < T_GU) return E_O + l0 * T_GU + q;
  q -= T_GU;
  if (q < T_D) return E_GU + l0 * T_D + q;
  q -= T_D;
  if (q < T_CD) return E_AB + e * T_CD + q;
  q -= T_CD;
  if (q < T_QU) return E_CD + e * T_QU + q;
  q -= T_QU;
  if (q < T_KVU) return E_QU + e * T_KVU + q;
  q -= T_KVU;
  if (q < T_O) return E_KVU + (l0 + 1) * T_O + q;
  q -= T_O;
  if (q < T_GU) return E_O + (l0 + 1) * T_GU + q;
  q -= T_GU;
  if (q < T_D) return E_GU + (l0 + 1) * T_D + q;
  q -= T_D;
  return T_AB + q;
}

DI void prep_phase(const P& p, char* smem) {
  float* sm = (float*)smem;
  const int t = tid_opaque();
  for (int task0 = bid_opaque(); task0 < 768 + T_AB; task0 += gridDim.x) {
    if (task0 >= 768) {
      transpose_task(p, sm, task0 - 768);
    } else {
      const int l = task0 / 192, rem = task0 % 192, cb = rem >> 1, kh = rem & 1;
      float* sc = sm;
      float* red = sm + 9 * 512;
      for (int idx = t; idx < 4608; idx += 256) {
        const int m = idx >> 9, k = kh * 512 + (idx & 511);
        const float cv = (m == 0) ? p.c_ctx[k] : p.c[(m - 1) * 1024 + k];
        sc[idx] = silu_f(cv);
      }
      __syncthreads();
      const int cc = t & 63, kq = t >> 6;
      const float* w = p.w_ada + ((size_t)l * 1024 + kh * 512 + kq * 128) * 6144 + cb * 64 + cc;
      float acc[9];
#pragma unroll
      for (int m = 0; m < 9; ++m) acc[m] = 0.f;
#pragma unroll 16
      for (int k = 0; k < 128; ++k) {
        const float wv = __builtin_nontemporal_load(w + (size_t)k * 6144);
#pragma unroll
        for (int m = 0; m < 9; ++m) acc[m] += sc[m * 512 + kq * 128 + k] * wv;
      }
#pragma unroll
      for (int m = 0; m < 9; ++m) red[(kq * 9 + m) * 64 + cc] = acc[m];
      __syncthreads();
      for (int idx = t; idx < 576; idx += 256) {
        const int m = idx >> 6, c2 = idx & 63;
        float s2 = red[(0 * 9 + m) * 64 + c2] + red[(1 * 9 + m) * 64 + c2] + red[(2 * 9 + m) * 64 + c2] +
                   red[(3 * 9 + m) * 64 + c2];
        if (kh == 0) s2 += p.b_ada[l * 6144 + cb * 64 + c2];
        atomicAdd(WSP(float, O_MOD) + ((size_t)l * 9 + m) * 6144 + cb * 64 + c2, s2);
      }
      __syncthreads();
    }
  }
  const int gt = bid_opaque() * 256 + t, ngt = gridDim.x * 256;
  for (int i = gt; i < 64 * 16; i += ngt) {
    const int pos = i >> 4, j = i & 15;
    const float inv = powf(10000.f, -(float)j / 16.f);
    const float a = (float)pos * inv;
    WSP(float, O_CS64)[2 * i] = cosf(a);
    WSP(float, O_CS64)[2 * i + 1] = sinf(a);
  }
  for (int i = gt; i < 64 * 8; i += ngt) {
    const int pos = i >> 3, j = i & 7;
    const float inv = powf(10000.f, -(float)j / 8.f);
    const float a = (float)pos * inv;
    WSP(float, O_CS32)[2 * i] = cosf(a);
    WSP(float, O_CS32)[2 * i + 1] = sinf(a);
  }
  for (int i = gt; i < 2048; i += ngt) {
    const int e = i >> 10, r = i & 1023;
    float v = 0.f;
    if (e == 1) v = 1.f / (1.f + expf(p.b_lb[r] - p.b_lb[1024 + r]));
    WSP(float, O_LBT)[i] = v;
  }
  for (int i4 = gt; i4 < 2 * 8 * 512 * 32; i4 += ngt) {
    const int i = i4 * 4;
    const int c = i & 127, pp = (i >> 7) & 511, b = (i >> 16) & 7, e = i >> 19;
    const f32x4 v = *(const f32x4*)(p.cache_a_k + (((size_t)b * 2 + e) * 512 + pp) * 128 + c);
    u32x2 o;
    o[0] = pack2(v[0], v[1]);
    o[1] = pack2(v[2], v[3]);
    *(u32x2*)(WSP(u16, O_KCA) + i) = o;
  }
  for (int i = gt; i < 2 * 8 * 64 * 128; i += ngt) {
    const int c = i & 127, pc = (i >> 7) & 63, b = (i >> 13) & 7, e = i >> 16;
    const float* src = p.cache_a_v + (((size_t)b * 2 + e) * 512 + pc * 8) * 128 + c;
    u32x4 o;
#pragma unroll
    for (int q = 0; q < 4; ++q) o[q] = pack2(src[(2 * q) * 128], src[(2 * q + 1) * 128]);
    *(u32x4*)(WSP(u16, O_VTAL) + ((size_t)((e * 8 + b) * 2 + (c >> 6)) * 64 + (c & 63)) * 1536 + 1024 + pc * 8) = o;
  }
  for (int i4 = gt; i4 < 2 * 8 * 512 * 64; i4 += ngt) {
    const int i = i4 * 4;
    const int c = i & 255, pp = (i >> 8) & 511, b = (i >> 17) & 7, o = i >> 20;
    const f32x4 v = *(const f32x4*)(p.cache_d_k + (((size_t)b * 2 + o) * 512 + pp) * 256 + c);
    u32x2 ov;
    ov[0] = pack2(v[0], v[1]);
    ov[1] = pack2(v[2], v[3]);
    *(u32x2*)(WSP(u16, O_KCD) + i) = ov;
  }
  for (int i = gt; i < 2 * 8 * 64 * 256; i += ngt) {
    const int c = i & 255, pc = (i >> 8) & 63, b = (i >> 14) & 7, o = i >> 17;
    const float* src = p.cache_d_v + (((size_t)b * 2 + o) * 512 + pc * 8) * 256 + c;
    u32x4 ov;
#pragma unroll
    for (int q = 0; q < 4; ++q) ov[q] = pack2(src[(2 * q) * 256], src[(2 * q + 1) * 256]);
    *(u32x4*)(WSP(u16, O_VTDL) + ((size_t)((o * 8 + b) * 4 + (c >> 6)) * 64 + (c & 63)) * 1536 + 1024 + pc * 8) = ov;
  }
  for (int i4 = gt; i4 < 2 * 8 * 512 * 8; i4 += ngt) {
    const int i = i4 * 4;
    const int c = i & 31, pp = (i >> 5) & 511, b = (i >> 14) & 7, o = i >> 17;
    const f32x4 v = *(const f32x4*)(p.cache_c_pe + (((size_t)b * 2 + o) * 512 + pp) * 32 + c);
    u32x2 ov;
    ov[0] = pack2(v[0], v[1]);
    ov[1] = pack2(v[2], v[3]);
    *(u32x2*)(WSP(u16, O_PECTX) + i) = ov;
  }
}

DI const float* x_input_row(const P& p, int R) {
  return R < NPR ? p.x_prompt + (size_t)R * 1024 : p.x_sample + (size_t)(R - NPR) * 1024;
}

DI void h0_phase(const P& p) {
  const int lane = tid_opaque() & 63;
  const int gw = bid_opaque() * 4 + (tid_opaque() >> 6), nw = gridDim.x * 4;
  for (int R0 = gw * 4; R0 < NROWS; R0 += nw * 4) {
    const float* md = WSP(float, O_MOD) + (size_t)(0 * 9 + mod_index(R0)) * 6144;
    f32x4 v[4][4];
#pragma unroll
    for (int rr = 0; rr < 4; ++rr) {
      const float* xr = x_input_row(p, R0 + rr);
#pragma unroll
      for (int j = 0; j < 4; ++j) v[rr][j] = *(const f32x4*)(xr + j * 256 + lane * 4);
    }
#pragma unroll
    for (int j = 0; j < 4; ++j) {
      const int c = j * 256 + lane * 4;
      const f32x4 sh = *(const f32x4*)(md + c), scl = *(const f32x4*)(md + 1024 + c);
#pragma unroll
      for (int rr = 0; rr < 4; ++rr) {
        u32x2 o;
        o[0] = pack2(v[rr][j][0] * (1.f + scl[0]) + sh[0], v[rr][j][1] * (1.f + scl[1]) + sh[1]);
        o[1] = pack2(v[rr][j][2] * (1.f + scl[2]) + sh[2], v[rr][j][3] * (1.f + scl[3]) + sh[3]);
        *(u32x2*)(WSP(u16, O_HM) + (size_t)(R0 + rr) * 1024 + c) = o;
      }
    }
  }
}

DI void ln_phase(const P& p, int l, int which) {
  const int lane = tid_opaque() & 63;
  const int gw = bid_opaque() * 4 + (tid_opaque() >> 6), nw = gridDim.x * 4;
  const float* g = p.ln_g + (l * 2 + which) * 1024;
  const float* bb = p.ln_b + (l * 2 + which) * 1024;
  const bool has_h = (which == 0) || (l < 3);
  const bool full = !has_h;
  const int ml = (which == 0) ? l : l + 1;
  const int so = (which == 0) ? 3 : 0;
  for (int R0 = gw * 4; R0 < NROWS; R0 += nw * 4) {
    f32x4 v[4][4];
    float s[4], q[4], mean[4], rs[4];
#pragma unroll
    for (int rr = 0; rr < 4; ++rr) {
      const float* xr = p.out + (size_t)(R0 + rr) * 1024;
#pragma unroll
      for (int j = 0; j < 4; ++j) v[rr][j] = *(const f32x4*)(xr + j * 256 + lane * 4);
    }
#pragma unroll
    for (int rr = 0; rr < 4; ++rr) {
      s[rr] = 0.f;
#pragma unroll
      for (int j = 0; j < 4; ++j) s[rr] += v[rr][j][0] + v[rr][j][1] + v[rr][j][2] + v[rr][j][3];
    }
#pragma unroll
    for (int o = 32; o >= 1; o >>= 1)
#pragma unroll
      for (int rr = 0; rr < 4; ++rr) s[rr] += __shfl_xor(s[rr], o);
#pragma unroll
    for (int rr = 0; rr < 4; ++rr) {
      mean[rr] = s[rr] * (1.f / 1024.f);
      q[rr] = 0.f;
#pragma unroll
      for (int j = 0; j < 4; ++j)
#pragma unroll
        for (int k = 0; k < 4; ++k) {
          v[rr][j][k] -= mean[rr];
          q[rr] += v[rr][j][k] * v[rr][j][k];
        }
    }
#pragma unroll
    for (int o = 32; o >= 1; o >>= 1)
#pragma unroll
      for (int rr = 0; rr < 4; ++rr) q[rr] += __shfl_xor(q[rr], o);
#pragma unroll
    for (int rr = 0; rr < 4; ++rr) rs[rr] = rsqrtf(q[rr] * (1.f / 1024.f) + 1e-5f);
    if (!full && lane < 4) {
      f32v2 st;
      st[0] = lane == 0 ? mean[0] : lane == 1 ? mean[1] : lane == 2 ? mean[2] : mean[3];
      st[1] = lane == 0 ? rs[0] : lane == 1 ? rs[1] : lane == 2 ? rs[2] : rs[3];
      *(f32v2*)(WSP(float, O_ST) + (size_t)(R0 + lane) * 2) = st;
    }
    const float* md = WSP(float, O_MOD) + (size_t)((has_h ? ml : 0) * 9 + mod_index(R0)) * 6144;
#pragma unroll
    for (int j = 0; j < 4; ++j) {
      const int c = j * 256 + lane * 4;
      const f32x4 gg = *(const f32x4*)(g + c), bv = *(const f32x4*)(bb + c);
      f32x4 sh, scl;
      if (has_h) {
        sh = *(const f32x4*)(md + so * 1024 + c);
        scl = *(const f32x4*)(md + (so + 1) * 1024 + c);
      }
#pragma unroll
      for (int rr = 0; rr < 4; ++rr) {
        f32x4 x;
#pragma unroll
        for (int k = 0; k < 4; ++k) x[k] = v[rr][j][k] * rs[rr] * gg[k] + bv[k];
        if (full) *(f32x4*)(p.out + (size_t)(R0 + rr) * 1024 + c) = x;
        if (has_h) {
          u32x2 o;
          o[0] = pack2(x[0] * (1.f + scl[0]) + sh[0], x[1] * (1.f + scl[1]) + sh[1]);
          o[1] = pack2(x[2] * (1.f + scl[2]) + sh[2], x[3] * (1.f + scl[3]) + sh[3]);
          *(u32x2*)(WSP(u16, O_HM) + (size_t)(R0 + rr) * 1024 + c) = o;
        }
      }
    }
  }
}

DI void hfin_phase(const P& p, int e) {
  const int lane = tid_opaque() & 63;
  const int gw = bid_opaque() * 4 + (tid_opaque() >> 6), nw = gridDim.x * 4;
  const float* of = WSP(float, O_OFB);
  const float* ob = of + (size_t)NROWS * 512;
  const float* gn = p.b_gnorm + e * 128;
  for (int R = gw; R < NROWS; R += nw) {
    const int c = lane * 8;
    float o[8];
    float ss = 0.f;
#pragma unroll
    for (int j = 0; j < 2; ++j) {
      const f32x4 a = *(const f32x4*)(of + (size_t)R * 512 + c + 4 * j);
      const f32x4 b = *(const f32x4*)(ob + (size_t)R * 512 + c + 4 * j);
#pragma unroll
      for (int k = 0; k < 4; ++k) {
        o[4 * j + k] = a[k] + b[k];
        ss += o[4 * j + k] * o[4 * j + k];
      }
    }
    ss += __shfl_xor(ss, 1);
    ss += __shfl_xor(ss, 2);
    ss += __shfl_xor(ss, 4);
    ss += __shfl_xor(ss, 8);
    const float r = rsqrtf(ss * (1.f / 128.f) + 1e-6f);
    const u32x4 gbv = *(const u32x4*)(WSP(u16, O_GB) + (size_t)R * 512 + c);
    const int v0 = c & 127;
    u32x4 outv;
#pragma unroll
    for (int q = 0; q < 4; ++q) {
      const float g0 = bf2f((u16)(gbv[q] & 0xffff)), g1 = bf2f((u16)(gbv[q] >> 16));
      outv[q] = pack2(o[2 * q] * r * gn[v0 + 2 * q] * g0, o[2 * q + 1] * r * gn[v0 + 2 * q + 1] * g1);
    }
    *(u32x4*)(WSP(u16, O_HM) + (size_t)R * 1024 + 512 + c) = outv;
  }
}

DI void post_odd_phase(const P& p, int o) {
  const int lane = tid_opaque() & 63;
  const int gw = bid_opaque() * 4 + (tid_opaque() >> 6), nw = gridDim.x * 4;
  const float* cs64 = WSP(float, O_CS64);
  const float* cs32 = WSP(float, O_CS32);
  u16 rcq[6], rkpe;
  u32x2 rckv, rkd;
  u32x4 rqd;
#define POST_LOAD(RR)                                                        \
  {                                                                          \
    const u16* pr_ = WSP(u16, O_PROJ) + (size_t)(RR) * 1792;                 \
    _Pragma("unroll") for (int j = 0; j < 6; ++j) rcq[j] = pr_[lane + 64 * j]; \
    rckv = *(const u32x2*)(pr_ + 384 + lane * 4);                            \
    rqd = *(const u32x4*)(pr_ + 640 + lane * 8);                             \
    rkd = *(const u32x2*)(pr_ + 1152 + lane * 4);                            \
    rkpe = pr_[1664 + (lane & 31)];                                          \
  }
  if (gw < NROWS) POST_LOAD(gw)
  for (int R = gw; R < NROWS; R += nw) {
    u16 ccq[6];
#pragma unroll
    for (int j = 0; j < 6; ++j) ccq[j] = rcq[j];
    const u32x2 cckv = rckv, ckd = rkd;
    const u32x4 cqd = rqd;
    const u16 ckpe = rkpe;
    { const int Rn = R + nw < NROWS ? R + nw : R; POST_LOAD(Rn) }
    const bool lat = R >= NPR;
    const int b = lat ? (R - NPR) >> 10 : R >> 8;
    const int tk = lat ? (R - NPR) & 1023 : R & 255;
    const int prow = tk >> 6, pcol = tk & 63;
    {
      float ss = 0.f;
#pragma unroll
      for (int j = 0; j < 6; ++j) {
        const float v = bf2f(ccq[j]);
        ss += v * v;
      }
      ss = wave_sum(ss);
      if (lane == 0) WSP(float, O_RCQ)[R] = rsqrtf(ss * (1.f / 384.f) + 1e-6f);
    }
    {
      const u32x2 raw = cckv;
      float v[4] = {bf2f((u16)(raw[0] & 0xffff)), bf2f((u16)(raw[0] >> 16)), bf2f((u16)(raw[1] & 0xffff)),
                    bf2f((u16)(raw[1] >> 16))};
      float ss = v[0] * v[0] + v[1] * v[1] + v[2] * v[2] + v[3] * v[3];
      ss = wave_sum(ss);
      const float r = rsqrtf(ss * (1.f / 256.f) + 1e-6f);
      const f32x4 g = *(const f32x4*)(p.c_kv_norm + o * 256 + lane * 4);
      f32x4 y;
#pragma unroll
      for (int k = 0; k < 4; ++k) y[k] = v[k] * r * g[k];
      u32x2 ov;
      ov[0] = pack2(y[0], y[1]);
      ov[1] = pack2(y[2], y[3]);
      *(u32x2*)(WSP(u16, O_CKVN) + (size_t)R * 256 + lane * 4) = ov;
      if (!lat) *(f32x4*)(p.out + OUT_CKV + (((size_t)b * 2 + o) * 256 + tk) * 256 + lane * 4) = y;
    }
    {
      const u32x4 raw = cqd;
      float v[8];
#pragma unroll
      for (int q = 0; q < 4; ++q) {
        v[2 * q] = bf2f((u16)(raw[q] & 0xffff));
        v[2 * q + 1] = bf2f((u16)(raw[q] >> 16));
      }
      float ss = 0.f;
#pragma unroll
      for (int k = 0; k < 8; ++k) ss += v[k] * v[k];
      ss += __shfl_xor(ss, 1);
      ss += __shfl_xor(ss, 2);
      ss += __shfl_xor(ss, 4);
      const float r = rsqrtf(ss * (1.f / 64.f) + 1e-6f);
      const int l8 = lane & 7;
#pragma unroll
      for (int k = 0; k < 8; ++k) v[k] = v[k] * r * p.d_q_norm[o * 64 + l8 * 8 + k];
      const bool first = (l8 & 2) == 0;
      const int pos = (l8 < 4) ? prow : pcol;
      u32x4 ov;
      float y[8];
#pragma unroll
      for (int k = 0; k < 8; ++k) {
        const float pv = __shfl_xor(v[k], 2);
        const int i = (l8 & 1) * 8 + k;
        const float cc = cs64[(pos * 16 + i) * 2], sn = cs64[(pos * 16 + i) * 2 + 1];
        const float rot = first ? v[k] * cc - pv * sn : v[k] * cc + pv * sn;
        y[k] = lat ? rot : v[k];
      }
#pragma unroll
      for (int q = 0; q < 4; ++q) ov[q] = pack2(y[2 * q], y[2 * q + 1]);
      *(u32x4*)(WSP(u16, O_QD) + (size_t)R * 512 + lane * 8) = ov;
    }
    {
      const u32x2 raw = ckd;
      float v[4] = {bf2f((u16)(raw[0] & 0xffff)), bf2f((u16)(raw[0] >> 16)), bf2f((u16)(raw[1] & 0xffff)),
                    bf2f((u16)(raw[1] >> 16))};
      float ss = v[0] * v[0] + v[1] * v[1] + v[2] * v[2] + v[3] * v[3];
      ss += __shfl_xor(ss, 1);
      ss += __shfl_xor(ss, 2);
      ss += __shfl_xor(ss, 4);
      ss += __shfl_xor(ss, 8);
      const float r = rsqrtf(ss * (1.f / 64.f) + 1e-6f);
      const int l16 = lane & 15;
      f32x4 y;
#pragma unroll
      for (int k = 0; k < 4; ++k) y[k] = v[k] * r * p.d_k_norm[o * 64 + l16 * 4 + k];
      if (!lat) *(f32x4*)(p.out + OUT_DK + (((size_t)b * 2 + o) * 256 + tk) * 256 + lane * 4) = y;
      const bool first = (l16 & 4) == 0;
      const int pos = (l16 < 8) ? prow : pcol;
      float z[4];
#pragma unroll
      for (int k = 0; k < 4; ++k) {
        const float pv = __shfl_xor(y[k], 4);
        const int i = (l16 & 3) * 4 + k;
        const float cc = cs64[(pos * 16 + i) * 2], sn = cs64[(pos * 16 + i) * 2 + 1];
        const float rot = first ? y[k] * cc - pv * sn : y[k] * cc + pv * sn;
        z[k] = lat ? rot : y[k];
      }
      u32x2 ov;
      ov[0] = pack2(z[0], z[1]);
      ov[1] = pack2(z[2], z[3]);
      *(u32x2*)(WSP(u16, O_KD) + (size_t)R * 256 + lane * 4) = ov;
    }
    {
      const float v = bf2f(ckpe);
      const float pv = __shfl_xor(v, 8);
      const int l32 = lane & 31;
      const bool first = (l32 & 8) == 0;
      const int pos = (l32 < 16) ? prow : pcol;
      const int i = l32 & 7;
      const float cc = cs32[(pos * 8 + i) * 2], sn = cs32[(pos * 8 + i) * 2 + 1];
      const float rot = first ? v * cc - pv * sn : v * cc + pv * sn;
      if (lane < 32) {
        WSP(u16, O_KPE)[(size_t)R * 32 + lane] = f2bf(lat ? rot : v);
        if (!lat) p.out[OUT_CPE + (((size_t)b * 2 + o) * 256 + tk) * 32 + lane] = v;
      }
    }
  }
#undef POST_LOAD
  const int gt = bid_opaque() * 256 + tid_opaque(), ngt = gridDim.x * 256;
  for (int i4 = gt; i4 < 8 * 512 * 64; i4 += ngt) {
    const int i = i4 * 4;
    const int c = i & 255, pp = (i >> 8) & 511, b = i >> 17;
    const f32x4 v = *(const f32x4*)(p.cache_c_kv + (((size_t)b * 2 + o) * 512 + pp) * 256 + c);
    u32x2 ov;
    ov[0] = pack2(v[0], v[1]);
    ov[1] = pack2(v[2], v[3]);
    *(u32x2*)(WSP(u16, O_CKVN) + (size_t)16384 * 256 + i) = ov;
  }
}

enum { G_EVEN_IN = 0, G_ODD_IN, G_UPS, G_OUTP, G_FFNUP, G_FFNDN };
enum { EP_EVEN_IN = 0, EP_ODD_IN, EP_QUP, EP_KVUP, EP_RESID, EP_SWIGLU };

constexpr int G_LDS_STRIDE = 72;

DI void gemm_phase(const P& p, char* smem, int kind, int l) {
  u16* As = (u16*)smem;
  u16* Bs = As + 2 * 128 * G_LDS_STRIDE;
  const int eo = l >> 1;
  int ntiles_total, NT1 = 1, split = 0x7fffffff;
  switch (kind) {
    case G_EVEN_IN: NT1 = 26; ntiles_total = 128 * 26; break;
    case G_ODD_IN: NT1 = 14; ntiles_total = 128 * 14; break;
    case G_UPS: NT1 = 6; split = 128 * 6; ntiles_total = 128 * 6 + 160 * 8; break;
    case G_OUTP: NT1 = 8; ntiles_total = 128 * 8; break;
    case G_FFNUP: NT1 = 44; ntiles_total = 128 * 44; break;
    default: NT1 = 8; ntiles_total = 128 * 8; break;
  }
  const int bid = bid_opaque();
  const int xcd = bid & 7, slot = bid >> 3, nslots = gridDim.x >> 3;
  const int per_xcd1 = (kind == G_UPS) ? 16 * 6 : ntiles_total / 8;
  const int per_xcd = (kind == G_UPS) ? 16 * 6 + 20 * 8 : per_xcd1;
  (void)split;
  u32x4 ra0[4], rb0[4], ra1[4], rb1[4];
  if ((bid >> 8) & 1) { __builtin_amdgcn_s_sleep(12); }
  bool first_tile = true;
#define TILE_DESC(J, M0, N0, AP, BP, LDA, LDB, KK, EPI)                                                   \
  {                                                                                                       \
    const bool sec_ = (J) >= per_xcd1;                                                                    \
    const int jj_ = sec_ ? (J) - per_xcd1 : (J);                                                          \
    const int mper_ = sec_ ? 20 : 16;                                                                     \
    int mg_, rem_;     \
    switch (kind) {                                                                                       \
      case G_EVEN_IN: mg_ = jj_ / 208; rem_ = jj_ - mg_ * 208; break;                                     \
      case G_ODD_IN: mg_ = jj_ / 112; rem_ = jj_ - mg_ * 112; break;                                      \
      case G_UPS: if (!sec_) { mg_ = jj_ / 48; rem_ = jj_ - mg_ * 48; } else { mg_ = jj_ >> 6; rem_ = jj_ & 63; } break; \
      case G_FFNUP: mg_ = jj_ / 352; rem_ = jj_ - mg_ * 352; break;                                       \
      default: mg_ = jj_ >> 6; rem_ = jj_ & 63; break;                                                    \
    }                                                                                                     \
    const bool small_ = (mper_ - mg_ * 8) < 8;                   \
    const int nn_ = small_ ? rem_ >> 2 : rem_ >> 3, mi2_ = small_ ? rem_ & 3 : rem_ & 7;                  \
    M0 = (xcd * mper_ + mg_ * 8 + mi2_) * 128;                                                            \
    N0 = nn_ * 128;                                                                                       \
    switch (kind) {                                                                                       \
      case G_EVEN_IN:                                                                                     \
        AP = WSP(u16, O_HM); LDA = 1024; BP = WSP(u16, O_WAB) + (size_t)eo * 3328 * 1024; LDB = 1024; KK = 1024; EPI = EP_EVEN_IN; break; \
      case G_ODD_IN:                                                                                      \
        AP = WSP(u16, O_HM); LDA = 1024; BP = WSP(u16, O_WCD) + (size_t)eo * 1792 * 1024; LDB = 1024; KK = 1024; EPI = EP_ODD_IN; break; \
      case G_UPS:                                                                                         \
        if (!sec_) { AP = WSP(u16, O_PROJ); LDA = 1792; BP = WSP(u16, O_WQU) + (size_t)eo * 768 * 384; LDB = 384; KK = 384; EPI = EP_QUP; } \
        else { AP = WSP(u16, O_CKVN); LDA = 256; BP = WSP(u16, O_WKVU) + (size_t)eo * 1024 * 256; LDB = 256; KK = 256; EPI = EP_KVUP; } \
        break;                                                                                            \
      case G_OUTP:                                                                                        \
        AP = WSP(u16, O_HM); LDA = 1024; BP = WSP(u16, O_WO) + (size_t)l * 1024 * 1024; LDB = 1024; KK = 1024; EPI = EP_RESID; break; \
      case G_FFNUP:                                                                                       \
        AP = WSP(u16, O_HM); LDA = 1024; BP = WSP(u16, O_WGU) + (size_t)l * 5632 * 1024; LDB = 1024; KK = 1024; EPI = EP_SWIGLU; break; \
      default:                                                                                            \
        AP = WSP(u16, O_ACT); LDA = 2816; BP = WSP(u16, O_WD) + (size_t)l * 1024 * 2816; LDB = 2816; KK = 2816; EPI = EP_RESID; break; \
    }                                                                                                     \
  }
  for (int j = slot; j < per_xcd; j += nslots) {
    const int t = tid_opaque(), lane = t & 63, wave = t >> 6;
    const int wm = wave >> 1, wn = wave & 1, r = lane & 31, h = lane >> 5;
    const u16 *A, *Bt, *An, *Btn;
    int lda, ldb, K, m0, n0, epi, ldan, ldbn, Kn, m0n, n0n, epin;
    TILE_DESC(j, m0, n0, A, Bt, lda, ldb, K, epi)
    {
      const int jn = (j + nslots < per_xcd) ? j + nslots : j;
      TILE_DESC(jn, m0n, n0n, An, Btn, ldan, ldbn, Kn, epin)
      (void)Kn; (void)epin;
    }
    f32x16 acc[2][2];
#pragma unroll
    for (int a = 0; a < 2; ++a)
#pragma unroll
      for (int b = 0; b < 2; ++b) acc[a][b] = zero16();
    const int KT = K >> 6;
    const int lrow = t >> 3, lkc = (t & 7) * 8;
    const u16* Ag = A + (size_t)m0 * lda;
    const u16* Bg = Bt + (size_t)n0 * ldb;
    const u16* Agn = An + (size_t)m0n * ldan;
    const u16* Bgn = Btn + (size_t)n0n * ldbn;
    const unsigned loA = (unsigned)(lrow * lda + lkc) * 2u, loB = (unsigned)(lrow * ldb + lkc) * 2u;
    const unsigned loAn = (unsigned)(lrow * ldan + lkc) * 2u, loBn = (unsigned)(lrow * ldbn + lkc) * 2u;
#define G_LOAD(RA, RB, V)                                                           \
  {                                                                                 \
    const int v_ = (V);                                                             \
    const bool nx_ = v_ >= KT;                                                      \
    const int kk_ = (nx_ ? v_ - KT : v_) * 128;                                     \
    const auto ra_ = __builtin_amdgcn_make_buffer_rsrc((void*)(nx_ ? Agn : Ag), (short)0, 0x40000000, 0x00020000); \
    const auto rb_ = __builtin_amdgcn_make_buffer_rsrc((void*)(nx_ ? Bgn : Bg), (short)0, 0x40000000, 0x00020000); \
    const int la_ = (nx_ ? ldan : lda) * 64, lb_ = (nx_ ? ldbn : ldb) * 64;         \
    const unsigned oa_ = nx_ ? loAn : loA, ob_ = nx_ ? loBn : loB;                  \
    _Pragma("unroll") for (int i = 0; i < 4; ++i) {                                 \
      RA[i] = __builtin_amdgcn_raw_buffer_load_b128(ra_, oa_, kk_ + i * la_, 0);    \
      RB[i] = __builtin_amdgcn_raw_buffer_load_b128(rb_, ob_, kk_ + i * lb_, 0);    \
    }                                                                               \
  }
#define G_STORE(RA, RB, BUF)                                                        \
  _Pragma("unroll") for (int i = 0; i < 4; ++i) {                                   \
    *(u32x4*)(As + (BUF) * 128 * G_LDS_STRIDE + (lrow + 32 * i) * G_LDS_STRIDE + lkc) = RA[i]; \
    *(u32x4*)(Bs + (BUF) * 128 * G_LDS_STRIDE + (lrow + 32 * i) * G_LDS_STRIDE + lkc) = RB[i]; \
  }
#define G_FRAGS(BUF)                                                                \
  {                                                                                 \
    const u16* Ab = As + (BUF) * 128 * G_LDS_STRIDE + (wm * 64 + r) * G_LDS_STRIDE + h * 8; \
    const u16* Bb = Bs + (BUF) * 128 * G_LDS_STRIDE + (wn * 64 + r) * G_LDS_STRIDE + h * 8; \
    _Pragma("unroll") for (int ks = 0; ks < 4; ++ks) {                              \
      fa[ks][0] = *(const bf16x8*)(Ab + ks * 16);                                   \
      fb[ks][0] = *(const bf16x8*)(Bb + ks * 16);                                   \
      fa[ks][1] = *(const bf16x8*)(Ab + 32 * G_LDS_STRIDE + ks * 16);               \
      fb[ks][1] = *(const bf16x8*)(Bb + 32 * G_LDS_STRIDE + ks * 16);               \
    }                                                                               \
  }
#define G_MFMAS()                                                                   \
  _Pragma("unroll") for (int ks = 0; ks < 4; ++ks) {                                \
    acc[0][0] = MFMA(fa[ks][0], fb[ks][0], acc[0][0]);                              \
    acc[0][1] = MFMA(fa[ks][0], fb[ks][1], acc[0][1]);                              \
    acc[1][0] = MFMA(fa[ks][1], fb[ks][0], acc[1][0]);                              \
    acc[1][1] = MFMA(fa[ks][1], fb[ks][1], acc[1][1]);                              \
  }
#define G_INTERLEAVE()                                                              \
  _Pragma("unroll") for (int q = 0; q < 8; ++q) {                                   \
    __builtin_amdgcn_sched_group_barrier(0x008, 1, 0);                              \
    __builtin_amdgcn_sched_group_barrier(0x200, 1, 0);                              \
  }                                                                                 \
  _Pragma("unroll") for (int q = 0; q < 8; ++q) {                                   \
    __builtin_amdgcn_sched_group_barrier(0x008, 1, 0);                              \
    __builtin_amdgcn_sched_group_barrier(0x020, 1, 0);                              \
  }
    bf16x8 fa[4][2], fb[4][2];
    if (first_tile) {
      first_tile = false;
      G_LOAD(ra0, rb0, 0)
      G_LOAD(ra1, rb1, 1)
      G_STORE(ra0, rb0, 0)
      G_LOAD(ra0, rb0, 2)
      __builtin_amdgcn_sched_barrier(0);
      __syncthreads();
    }
    for (int kt = 0; kt < KT; kt += 2) {
      G_FRAGS(0)
      __builtin_amdgcn_sched_barrier(0);
      G_STORE(ra1, rb1, 1)
      G_LOAD(ra1, rb1, kt + 3)
      G_MFMAS()
      G_INTERLEAVE()
      __builtin_amdgcn_sched_barrier(0);
      __syncthreads();
      G_FRAGS(1)
      __builtin_amdgcn_sched_barrier(0);
      G_STORE(ra0, rb0, 0)
      G_LOAD(ra0, rb0, kt + 4)
      G_MFMAS()
      G_INTERLEAVE()
      __builtin_amdgcn_sched_barrier(0);
      __syncthreads();
    }
#undef G_FRAGS
#undef G_MFMAS
#undef G_INTERLEAVE
#undef G_LOAD
#undef G_STORE
    const int rowb = m0 + wm * 64;
    const int colb = n0 + wn * 64;
    const bool lat = m0 >= NPR && m0 < NROWS;
    const int mi_mod = mod_index(m0 < NROWS ? m0 : 0);
    if (epi == EP_RESID) {
      const int gsel = (kind == G_OUTP) ? 2 : 5;
      const bool from_input = (kind == G_OUTP) && (l == 0);
      const int pln = (kind == G_OUTP) ? (l - 1) * 2 + 1 : l * 2;
      const float* md = WSP(float, O_MOD) + (size_t)(l * 9 + mi_mod) * 6144 + gsel * 1024;
      const char* xb0 = (const char*)(from_input ? x_input_row(p, m0) : p.out + (size_t)m0 * 1024);
      char* ob0 = (char*)(p.out + (size_t)m0 * 1024);
      const char* st0 = (const char*)WSP(float, O_ST);
      const int col0 = colb + r, col1 = col0 + 32;
      const unsigned lo0 = ((unsigned)(wm * 64 + 4 * h) * 1024u + (unsigned)col0) * 4u;
      const unsigned ls0 = (unsigned)(rowb + 4 * h) * 8u;
      const float gate0 = md[col0], gate1 = md[col1];
      float g0 = 1.f, g1 = 1.f, b0 = 0.f, b1 = 0.f;
      if (!from_input) {
        g0 = p.ln_g[pln * 1024 + col0]; g1 = p.ln_g[pln * 1024 + col1];
        b0 = p.ln_b[pln * 1024 + col0]; b1 = p.ln_b[pln * 1024 + col1];
      }
#pragma unroll
      for (int mi = 0; mi < 2; ++mi)
#pragma unroll
        for (int i = 0; i < 16; ++i) {
          const int ro = mi * 32 + crow(i, 0);
          float mean = 0.f, rstd = 1.f;
          if (!from_input) {
            const f32v2 st = *(const f32v2*)(st0 + ls0 + (unsigned)(ro * 8));
            mean = st[0];
            rstd = st[1];
          }
          const unsigned o0 = lo0 + (unsigned)(ro * 4096);
          const float x0 = (*(const float*)(xb0 + o0) - mean) * rstd * g0 + b0;
          const float x1 = (*(const float*)(xb0 + o0 + 128u) - mean) * rstd * g1 + b1;
          *(float*)(ob0 + o0) = ALPHA_F * x0 + gate0 * acc[mi][0][i];
          *(float*)(ob0 + o0 + 128u) = ALPHA_F * x1 + gate1 * acc[mi][1][i];
        }
    } else if (epi == EP_SWIGLU) {
      const int j = ((n0 >> 6) + wn) * 32 + r;
      u16* act = WSP(u16, O_ACT);
      const unsigned lofs = ((unsigned)(rowb + 4 * h) * 2816u + (unsigned)j) * 2u;
#pragma unroll
      for (int mi = 0; mi < 2; ++mi)
#pragma unroll
        for (int i = 0; i < 16; ++i)
          st_u16(act, lofs + (unsigned)((mi * 32 + crow(i, 0)) * 2816 * 2), f2bf(silu_f(acc[mi][0][i]) * acc[mi][1][i]));
    } else if (epi == EP_EVEN_IN) {
      const float* cs64 = WSP(float, O_CS64);
#pragma unroll
      for (int ni = 0; ni < 2; ++ni) {
        const int cbase = colb + ni * 32;
        const int col = cbase + r;
        if (cbase < 640) {
          u16* dst0 = cbase < 512 ? WSP(u16, O_QA) : WSP(u16, O_KA);
          const int ldd = cbase < 512 ? 512 : 128;
          const unsigned lofs = ((unsigned)(rowb + 4 * h) * (unsigned)ldd + (unsigned)(cbase < 512 ? col : col - 512)) * 2u;
          const bool rowblk = (cbase & 32) == 0;
          const bool first = (r & 16) == 0;
#pragma unroll
          for (int mi = 0; mi < 2; ++mi)
#pragma unroll
            for (int i = 0; i < 16; ++i) {
              if ((i & 3) == 0) SB();
              const int R = rowb + mi * 32 + crow(i, h);
              float v = acc[mi][ni][i];
              const float pv = __shfl_xor(v, 16);
              if (lat) {
                const int tk = (R - NPR) & 1023;
                const int pos = rowblk ? (tk >> 6) : (tk & 63);
                const float cc = cs64[(pos * 16 + (r & 15)) * 2], sn = cs64[(pos * 16 + (r & 15)) * 2 + 1];
                v = first ? v * cc - pv * sn : v * cc + pv * sn;
              } else if (cbase >= 512) {
                p.out[OUT_AK + (((size_t)(R >> 8) * 2 + eo) * 256 + (R & 255)) * 128 + (col - 512)] = v;
              }
              st_u16(dst0, lofs + (unsigned)((mi * 32 + crow(i, 0)) * 2) * (unsigned)ldd, f2bf(v));
            }
        } else if (cbase < 768) {
          const int c = col - 640, kvh = c >> 6, d = c & 63;
#pragma unroll
          for (int mi = 0; mi < 2; ++mi)
#pragma unroll
            for (int g4 = 0; g4 < 4; ++g4) {
              SB();
              const int R0 = rowb + mi * 32 + 8 * g4 + 4 * h;
              u32x2 ov;
              ov[0] = pack2(acc[mi][ni][4 * g4], acc[mi][ni][4 * g4 + 1]);
              ov[1] = pack2(acc[mi][ni][4 * g4 + 2], acc[mi][ni][4 * g4 + 3]);
              if (lat) {
                const int b = (R0 - NPR) >> 10, tk = (R0 - NPR) & 1023;
                *(u32x2*)(WSP(u16, O_VTAL) + ((size_t)((eo * 8 + b) * 2 + kvh) * 64 + d) * 1536 + tk) = ov;
              } else {
                const int b = R0 >> 8, tk = R0 & 255;
                *(u32x2*)(WSP(u16, O_VTAP) + ((size_t)(b * 2 + kvh) * 64 + d) * 256 + tk) = ov;
#pragma unroll
                for (int k = 0; k < 4; ++k)
                  p.out[OUT_AV + (((size_t)b * 2 + eo) * 256 + tk + k) * 128 + c] = acc[mi][ni][4 * g4 + k];
              }
            }
        } else if (cbase < 1792 || cbase >= 2816) {
          u16* dst;
          bool do_silu = true;
          int cofs;
          if (cbase < 1280) { dst = WSP(u16, O_QB); cofs = col - 768; }
          else if (cbase < 1792) { dst = WSP(u16, O_IB); cofs = col - 1280; do_silu = false; }
          else { dst = WSP(u16, O_GB); cofs = col - 2816; }
          const unsigned lofs = ((unsigned)(rowb + 4 * h) * 512u + (unsigned)cofs) * 2u;
#pragma unroll
          for (int mi = 0; mi < 2; ++mi)
#pragma unroll
            for (int i = 0; i < 16; ++i) {
              if ((i & 3) == 0) SB();
              const int R = rowb + mi * 32 + crow(i, h);
              const float v = acc[mi][ni][i];
              st_u16(dst, lofs + (unsigned)((mi * 32 + crow(i, 0)) * 512 * 2), f2bf(do_silu ? silu_f(v) : v));
            }
        } else {
          const bool fwd = cbase < 2304;
          const int cc = col - (fwd ? 1792 : 2304);
          const float lb = WSP(float, O_LBT)[(eo * 2 + (fwd ? 0 : 1)) * 512 + cc];
          float* dst = WSP(float, fwd ? O_FF : O_FB);
          const unsigned lofs = ((unsigned)(rowb + 4 * h) * 512u + (unsigned)cc) * 4u;
#pragma unroll
          for (int mi = 0; mi < 2; ++mi)
#pragma unroll
            for (int i = 0; i < 16; ++i) {
              if ((i & 3) == 0) SB();
              const int R = rowb + mi * 32 + crow(i, h);
              st_f32(dst, lofs + (unsigned)((mi * 32 + crow(i, 0)) * 512 * 4), lb + (1.f - lb) * sigmoid_f(acc[mi][ni][i]));
            }
        }
      }
    } else if (epi == EP_ODD_IN) {
#pragma unroll
      for (int ni = 0; ni < 2; ++ni) {
        const int cbase = colb + ni * 32;
        const int col = cbase + r;
        if (cbase >= 1408 && cbase < 1664) {
          const int c = col - 1408, kvh = c >> 6, d = c & 63;
#pragma unroll
          for (int mi = 0; mi < 2; ++mi)
#pragma unroll
            for (int g4 = 0; g4 < 4; ++g4) {
              SB();
              const int R0 = rowb + mi * 32 + 8 * g4 + 4 * h;
              u32x2 ov;
              ov[0] = pack2(acc[mi][ni][4 * g4], acc[mi][ni][4 * g4 + 1]);
              ov[1] = pack2(acc[mi][ni][4 * g4 + 2], acc[mi][ni][4 * g4 + 3]);
              if (lat) {
                const int b = (R0 - NPR) >> 10, tk = (R0 - NPR) & 1023;
                *(u32x2*)(WSP(u16, O_VTDL) + ((size_t)((eo * 8 + b) * 4 + kvh) * 64 + d) * 1536 + tk) = ov;
              } else {
                const int b = R0 >> 8, tk = R0 & 255;
                *(u32x2*)(WSP(u16, O_VTDP) + ((size_t)(b * 4 + kvh) * 64 + d) * 256 + tk) = ov;
#pragma unroll
                for (int k = 0; k < 4; ++k)
                  p.out[OUT_DV + (((size_t)b * 2 + eo) * 256 + tk + k) * 256 + c] = acc[mi][ni][4 * g4 + k];
              }
            }
        } else if (cbase < 1696) {
          u16* dst = WSP(u16, O_PROJ);
          const unsigned lofs = ((unsigned)(rowb + 4 * h) * 1792u + (unsigned)col) * 2u;
#pragma unroll
          for (int mi = 0; mi < 2; ++mi)
#pragma unroll
            for (int i = 0; i < 16; ++i) {
              if ((i & 3) == 0) SB();
              const int R = rowb + mi * 32 + crow(i, h);
              st_u16(dst, lofs + (unsigned)((mi * 32 + crow(i, 0)) * 1792 * 2), f2bf(acc[mi][ni][i]));
            }
        }
      }
    } else if (epi == EP_QUP) {
      const float* cs32 = WSP(float, O_CS32);
      const float* rcq = WSP(float, O_RCQ);
#pragma unroll
      for (int ni = 0; ni < 2; ++ni) {
        const int cbase = colb + ni * 32;
        const int col = cbase + r;
        const bool ropeblk = ((cbase >> 5) % 3) == 2;
        const bool first = (r & 8) == 0;
        u16* dst = WSP(u16, O_QC);
        const unsigned lofs = ((unsigned)(rowb + 4 * h) * 768u + (unsigned)col) * 2u;
#pragma unroll
        for (int mi = 0; mi < 2; ++mi)
#pragma unroll
          for (int i = 0; i < 16; ++i) {
            if ((i & 3) == 0) SB();
            const int R = rowb + mi * 32 + crow(i, h);
            float v = acc[mi][ni][i] * rcq[R];
            const float pv = __shfl_xor(v, 8);
            if (lat && ropeblk) {
              const int tk = (R - NPR) & 1023;
              const int pos = (r < 16) ? (tk >> 6) : (tk & 63);
              const float cc = cs32[(pos * 8 + (r & 7)) * 2], sn = cs32[(pos * 8 + (r & 7)) * 2 + 1];
              v = first ? v * cc - pv * sn : v * cc + pv * sn;
            }
            st_u16(dst, lofs + (unsigned)((mi * 32 + crow(i, 0)) * 768 * 2), f2bf(v));
          }
      }
    } else {
#pragma unroll
      for (int ni = 0; ni < 2; ++ni) {
        const int cbase = colb + ni * 32;
        const int col = cbase + r;
        const int head = col >> 7, hc = col & 127;
        if ((cbase & 64) == 0) {
          u16* dst = WSP(u16, O_KN);
          const unsigned lofs = ((unsigned)(rowb + 4 * h) * 512u + (unsigned)(head * 64 + hc)) * 2u;
#pragma unroll
          for (int mi = 0; mi < 2; ++mi)
#pragma unroll
            for (int i = 0; i < 16; ++i) {
              if ((i & 3) == 0) SB();
              const int R = rowb + mi * 32 + crow(i, h);
              st_u16(dst, lofs + (unsigned)((mi * 32 + crow(i, 0)) * 512 * 2), f2bf(acc[mi][ni][i]));
            }
        } else {
          const int d = hc - 64;
#pragma unroll
          for (int mi = 0; mi < 2; ++mi)
#pragma unroll
            for (int g4 = 0; g4 < 4; ++g4) {
              SB();
              const int R0 = rowb + mi * 32 + 8 * g4 + 4 * h;
              u32x2 ov;
              ov[0] = pack2(acc[mi][ni][4 * g4], acc[mi][ni][4 * g4 + 1]);
              ov[1] = pack2(acc[mi][ni][4 * g4 + 2], acc[mi][ni][4 * g4 + 3]);
              u16* dp;
              if (R0 < NPR) dp = WSP(u16, O_VTCP) + ((size_t)((R0 >> 8) * 8 + head) * 64 + d) * 256 + (R0 & 255);
              else if (R0 < NROWS)
                dp = WSP(u16, O_VTCL) + ((size_t)(((R0 - NPR) >> 10) * 8 + head) * 64 + d) * 1536 + ((R0 - NPR) & 1023);
              else
                dp = WSP(u16, O_VTCL) + ((size_t)(((R0 - NROWS) >> 9) * 8 + head) * 64 + d) * 1536 + 1024 + ((R0 - NROWS) & 511);
              *(u32x2*)dp = ov;
            }
        }
      }
    }
  }
}

struct AttnArgs {
  const u16* Q; int ldq;
  const u16* K0; int ldk0; const u16* PE0; int kb0, ke0;
  const u16* K1; int ldk1; const u16* PE1; int ke1;
  const u16* VT; int ldvt; int vtoff1;
  int banded; int qpos0;
  int has_sink; float sink;
  float scale;
  u16* O;
};

template <int DQK>
DI void attn_item(char* smem, const AttnArgs& a) {
  constexpr int KSTR = DQK + 8;
  constexpr int VSTR = 72;
  constexpr int NKS = DQK / 16;
  constexpr int ASTAGE = 64 * KSTR + 64 * VSTR;
  u16* Ks0 = (u16*)smem;
  const int t = tid_opaque(), lane = t & 63, w = t >> 6, r = lane & 31, h = lane >> 5;
  bf16x8 qf[NKS];
  {
    const u16* qp = a.Q + (size_t)(32 * w + r) * a.ldq + 8 * h;
#pragma unroll
    for (int ks = 0; ks < NKS; ++ks) qf[ks] = *(const bf16x8*)(qp + 16 * ks);
  }
  const float sl2 = a.scale * LOG2E;
  float m = a.has_sink ? a.sink * LOG2E : -1e30f;
  float lsum = a.has_sink ? 1.f : 0.f;
  f32x16 O0 = zero16(), O1 = zero16();
  const int qp_me = a.qpos0 + 32 * w + r;
  const int n0 = (a.ke0 - a.kb0) >> 6, nt = n0 + (a.ke1 >> 6);
  u32x4 kreg[2], vreg[2], preg;
#define A_ISSUE(TI)                                                                          \
  {                                                                                          \
    const int ti_ = (TI);                                                                    \
    const bool s1_ = ti_ >= n0;                                                              \
    const u16* Kp_ = s1_ ? a.K1 : a.K0;                                                      \
    const int ldk_ = s1_ ? a.ldk1 : a.ldk0;                                                  \
    const int k0_ = s1_ ? (ti_ - n0) * 64 : a.kb0 + ti_ * 64;                                \
    const int vo_ = (s1_ ? a.vtoff1 : 0) + k0_;                                              \
    _Pragma("unroll") for (int i = 0; i < 2; ++i) {                                          \
      const int c = t + 256 * i, key = c >> 3, dc = c & 7;                                   \
      kreg[i] = *(const u32x4*)(Kp_ + (size_t)(k0_ + key) * ldk_ + dc * 8);                  \
      vreg[i] = *(const u32x4*)(a.VT + (size_t)key * a.ldvt + vo_ + dc * 8);                 \
    }                                                                                        \
    if (DQK == 96) {                                                                         \
      const u16* PEp_ = s1_ ? a.PE1 : a.PE0;                                                 \
      preg = *(const u32x4*)(PEp_ + (size_t)(k0_ + (t >> 2)) * 32 + (t & 3) * 8);            \
    }                                                                                        \
  }
  A_ISSUE(0)
  for (int ti = 0; ti < nt; ++ti) {
    {
      const bool seg1 = ti >= n0;
      const int key0 = seg1 ? (ti - n0) * 64 : a.kb0 + ti * 64;
      const bool band = a.banded && !seg1;
      u16* Ks = Ks0 + (ti & 1) * ASTAGE;
      u16* Vs = Ks + 64 * KSTR;
#pragma unroll
      for (int i = 0; i < 2; ++i) {
        const int c = t + 256 * i, key = c >> 3, dc = c & 7;
        *(u32x4*)(Ks + key * KSTR + dc * 8) = kreg[i];
        *(u32x4*)(Vs + key * VSTR + dc * 8) = vreg[i];
      }
      if (DQK == 96) *(u32x4*)(Ks + (t >> 2) * KSTR + 64 + (t & 3) * 8) = preg;
      __syncthreads();
      A_ISSUE(ti + 1 < nt ? ti + 1 : ti)
      __builtin_amdgcn_sched_barrier(0);
      f32x16 S0 = zero16(), S1 = zero16();
      __builtin_amdgcn_s_setprio(1);
#pragma unroll
      for (int ks = 0; ks < NKS; ++ks) {
        const bf16x8 k0 = *(const bf16x8*)(Ks + r * KSTR + 16 * ks + 8 * h);
        const bf16x8 k1 = *(const bf16x8*)(Ks + (32 + r) * KSTR + 16 * ks + 8 * h);
        S0 = MFMA(k0, qf[ks], S0);
        S1 = MFMA(k1, qf[ks], S1);
      }
      __builtin_amdgcn_s_setprio(0);
      float tmax = -INFINITY;
#pragma unroll
      for (int i = 0; i < 16; ++i) {
        float x0 = S0[i] * sl2, x1 = S1[i] * sl2;
        if (band) {
          const int kp0 = key0 + crow(i, h), kp1 = kp0 + 32;
          int d0 = qp_me - kp0, d1 = qp_me - kp1;
          d0 = d0 < 0 ? -d0 : d0;
          d1 = d1 < 0 ? -d1 : d1;
          if (d0 > 128) x0 = -INFINITY;
          if (d1 > 128) x1 = -INFINITY;
        }
        S0[i] = x0;
        S1[i] = x1;
        tmax = fmaxf(tmax, fmaxf(x0, x1));
      }
      tmax = xhalf_max(tmax);
      const float mnew = (tmax > m + 8.f) ? tmax : m;
      const float alpha = __builtin_amdgcn_exp2f(m - mnew);
      float rs = 0.f;
#pragma unroll
      for (int i = 0; i < 16; ++i) {
        S0[i] = __builtin_amdgcn_exp2f(S0[i] - mnew);
        S1[i] = __builtin_amdgcn_exp2f(S1[i] - mnew);
        rs += S0[i] + S1[i];
      }
      rs = xhalf_sum(rs);
      lsum = lsum * alpha + rs;
      m = mnew;
#pragma unroll
      for (int i = 0; i < 16; ++i) {
        O0[i] *= alpha;
        O1[i] *= alpha;
      }
      __builtin_amdgcn_s_setprio(1);
      const u16* v0p = Vs + r * VSTR + 4 * h;
      const u16* v1p = Vs + (32 + r) * VSTR + 4 * h;
      {
        const bf16x8 pb = pack8<0>(S0);
        O0 = MFMA(cat4(*(const s16x4*)(v0p + 0), *(const s16x4*)(v0p + 8)), pb, O0);
        O1 = MFMA(cat4(*(const s16x4*)(v1p + 0), *(const s16x4*)(v1p + 8)), pb, O1);
      }
      {
        const bf16x8 pb = pack8<1>(S0);
        O0 = MFMA(cat4(*(const s16x4*)(v0p + 16), *(const s16x4*)(v0p + 24)), pb, O0);
        O1 = MFMA(cat4(*(const s16x4*)(v1p + 16), *(const s16x4*)(v1p + 24)), pb, O1);
      }
      {
        const bf16x8 pb = pack8<0>(S1);
        O0 = MFMA(cat4(*(const s16x4*)(v0p + 32), *(const s16x4*)(v0p + 40)), pb, O0);
        O1 = MFMA(cat4(*(const s16x4*)(v1p + 32), *(const s16x4*)(v1p + 40)), pb, O1);
      }
      {
        const bf16x8 pb = pack8<1>(S1);
        O0 = MFMA(cat4(*(const s16x4*)(v0p + 48), *(const s16x4*)(v0p + 56)), pb, O0);
        O1 = MFMA(cat4(*(const s16x4*)(v1p + 48), *(const s16x4*)(v1p + 56)), pb, O1);
      }
      __builtin_amdgcn_s_setprio(0);
    }
  }
  __syncthreads();
#undef A_ISSUE
  const float inv = 1.f / lsum;
  u16* op = a.O + (size_t)(32 * w + r) * 1024 + 4 * h;
#pragma unroll
  for (int g4 = 0; g4 < 4; ++g4) {
    u32x2 o0, o1;
    o0[0] = pack2(O0[4 * g4] * inv, O0[4 * g4 + 1] * inv);
    o0[1] = pack2(O0[4 * g4 + 2] * inv, O0[4 * g4 + 3] * inv);
    o1[0] = pack2(O1[4 * g4] * inv, O1[4 * g4 + 1] * inv);
    o1[1] = pack2(O1[4 * g4 + 2] * inv, O1[4 * g4 + 3] * inv);
    *(u32x2*)(op + 8 * g4) = o0;
    *(u32x2*)(op + 32 + 8 * g4) = o1;
  }
}

DI void hgrn_item(char* smem, const P& p, int e, int item) {
  u16* Qs = (u16*)smem;
  u16* Ks = Qs + 32 * 136;
  u16* KhT = Ks + 32 * 136;
  u16* VTs = KhT + 128 * 40;
  float* dec = (float*)(VTs + 128 * 40);
  float* Tx = dec + 128;
  const int t = tid_opaque(), lane = t & 63, w = t >> 6, r = lane & 31, hh = lane >> 5;
  const bool lat = item < 64;
  int b, hd, dir;
  if (lat) { b = item >> 3; hd = (item >> 1) & 3; dir = item & 1; }
  else { const int q = item - 64; b = q >> 3; hd = (q >> 1) & 3; dir = q & 1; }
  const int L = lat ? 1024 : 256;
  const int rowbase = lat ? NPR + b * 1024 : b * 256;
  const int nchunks = L >> 5;
  const float* Fsrc = WSP(float, dir ? O_FB : O_FF) + hd * 128;
  const u16* Qsrc = WSP(u16, O_QB) + hd * 128;
  const u16* Vsrc = WSP(u16, O_IB) + hd * 128;
  float* Odst = WSP(float, O_OFB) + (size_t)dir * NROWS * 512 + hd * 128;
  f32x16 St[4];
  if (lat) {
    const float* s0 = p.state_b + ((((size_t)b * 2 + e) * 2 + dir) * 4 + hd) * 16384;
#pragma unroll
    for (int kb = 0; kb < 4; ++kb)
#pragma unroll
      for (int i = 0; i < 16; ++i) St[kb][i] = s0[(size_t)(32 * kb + crow(i, hh)) * 128 + 32 * w + r];
  } else {
#pragma unroll
    for (int kb = 0; kb < 4; ++kb) St[kb] = zero16();
  }
  const int kk = 32 * w + r, half = hh;
  float fr[16];
  unsigned qp[8], vp[8];
#pragma unroll
  for (int i = 0; i < 8; ++i) {
    const int tt = 16 * half + 2 * i;
    const int row0 = rowbase + (dir ? L - 1 - tt : tt);
    const int row1 = dir ? row0 - 1 : row0 + 1;
    fr[2 * i] = Fsrc[(size_t)row0 * 512 + kk];
    fr[2 * i + 1] = Fsrc[(size_t)row1 * 512 + kk];
    qp[i] = (unsigned)Qsrc[(size_t)row0 * 512 + kk] | ((unsigned)Qsrc[(size_t)row1 * 512 + kk] << 16);
    vp[i] = (unsigned)Vsrc[(size_t)row0 * 512 + kk] | ((unsigned)Vsrc[(size_t)row1 * 512 + kk] << 16);
  }
  for (int n = 0; n < nchunks; ++n) {
    float cl[16];
    {
      float c = 0.f;
#pragma unroll
      for (int i = 0; i < 16; ++i) {
        c += __logf(fmaxf(fr[i], 1e-30f));
        cl[i] = c;
      }
      cl[15] = c;
    }
    {
      float T0, T1;
      {
        auto rr2 = __builtin_amdgcn_permlane32_swap(__float_as_uint(cl[15]), __float_as_uint(cl[15]), false, false);
        T0 = __uint_as_float(rr2[0]);
        T1 = __uint_as_float(rr2[1]);
      }
      const float last = T0 + T1, off = half ? T0 : 0.f;
      float khv[16];
#pragma unroll
      for (int i = 0; i < 16; ++i) {
        const float cum = cl[i] + off;
        const int s = 16 * half + i;
        const float kvv = 1.f - fr[i];
        const float qv = __uint_as_float((i & 1) ? (qp[i >> 1] & 0xffff0000u) : (qp[i >> 1] << 16));
        Qs[s * 136 + kk] = f2bf(qv * 0.08838834764831845f * __expf(cum));
        Ks[s * 136 + kk] = f2bf(kvv * __expf(fminf(-cum, 80.f)));
        khv[i] = kvv * __expf(last - cum);
      }
      u32x4 k0, k1, v0, v1;
#pragma unroll
      for (int q = 0; q < 4; ++q) {
        k0[q] = pack2(khv[2 * q], khv[2 * q + 1]);
        k1[q] = pack2(khv[8 + 2 * q], khv[8 + 2 * q + 1]);
        v0[q] = vp[q];
        v1[q] = vp[4 + q];
      }
      *(u32x4*)(KhT + kk * 40 + 16 * half) = k0;
      *(u32x4*)(KhT + kk * 40 + 16 * half + 8) = k1;
      *(u32x4*)(VTs + kk * 40 + 16 * half) = v0;
      *(u32x4*)(VTs + kk * 40 + 16 * half + 8) = v1;
      if (half == 0) dec[kk] = __expf(last);
    }
    if (n + 1 < nchunks) {
#pragma unroll
      for (int i = 0; i < 8; ++i) {
        const int tt = (n + 1) * 32 + 16 * half + 2 * i;
        const int row0 = rowbase + (dir ? L - 1 - tt : tt);
        const int row1 = dir ? row0 - 1 : row0 + 1;
        fr[2 * i] = Fsrc[(size_t)row0 * 512 + kk];
        fr[2 * i + 1] = Fsrc[(size_t)row1 * 512 + kk];
        qp[i] = (unsigned)Qsrc[(size_t)row0 * 512 + kk] | ((unsigned)Qsrc[(size_t)row1 * 512 + kk] << 16);
        vp[i] = (unsigned)Vsrc[(size_t)row0 * 512 + kk] | ((unsigned)Vsrc[(size_t)row1 * 512 + kk] << 16);
      }
    }
    __syncthreads();
    __builtin_amdgcn_s_setprio(1);
    f32x16 oacc = zero16();
#pragma unroll
    for (int kb = 0; kb < 4; ++kb) {
      const u16* qp = Qs + r * 136 + 32 * kb + 4 * hh;
      oacc = MFMA(pack8<0>(St[kb]), cat4(*(const s16x4*)(qp), *(const s16x4*)(qp + 8)), oacc);
      oacc = MFMA(pack8<1>(St[kb]), cat4(*(const s16x4*)(qp + 16), *(const s16x4*)(qp + 24)), oacc);
    }
    {
      f32x16 at = zero16();
#pragma unroll
      for (int ks = 0; ks < 8; ++ks) {
        const bf16x8 ka = *(const bf16x8*)(Ks + r * 136 + 16 * ks + 8 * hh);
        const bf16x8 qb = *(const bf16x8*)(Qs + r * 136 + 16 * ks + 8 * hh);
        at = MFMA(ka, qb, at);
      }
#pragma unroll
      for (int i = 0; i < 16; ++i)
        if (crow(i, hh) > r) at[i] = 0.f;
      const u16* vp = VTs + (32 * w + r) * 40 + 4 * hh;
      oacc = MFMA(cat4(*(const s16x4*)(vp), *(const s16x4*)(vp + 8)), pack8<0>(at), oacc);
      oacc = MFMA(cat4(*(const s16x4*)(vp + 16), *(const s16x4*)(vp + 24)), pack8<1>(at), oacc);
    }
#pragma unroll
    for (int kb = 0; kb < 4; ++kb) {
#pragma unroll
      for (int g4 = 0; g4 < 4; ++g4) {
        const f32x4 dv = *(const f32x4*)(dec + 32 * kb + 8 * g4 + 4 * hh);
#pragma unroll
        for (int k = 0; k < 4; ++k) St[kb][4 * g4 + k] *= dv[k];
      }
#pragma unroll
      for (int ks = 0; ks < 2; ++ks) {
        const bf16x8 ka = *(const bf16x8*)(KhT + (32 * kb + r) * 40 + 16 * ks + 8 * hh);
        const bf16x8 vb = *(const bf16x8*)(VTs + (32 * w + r) * 40 + 16 * ks + 8 * hh);
        St[kb] = MFMA(ka, vb, St[kb]);
      }
    }
    __builtin_amdgcn_s_setprio(0);
    {
      const int tt = n * 32 + r;
      const int row = rowbase + (dir ? L - 1 - tt : tt);
      float* od = Odst + (size_t)row * 512 + 32 * w + 4 * hh;
#pragma unroll
      for (int g4 = 0; g4 < 4; ++g4) {
        f32x4 v;
#pragma unroll
        for (int k = 0; k < 4; ++k) v[k] = oacc[4 * g4 + k];
        *(f32x4*)(od + 8 * g4) = v;
      }
    }
    __syncthreads();
  }
  if (!lat) {
    float* sd = p.out + OUT_SB + ((((size_t)b * 2 + e) * 2 + dir) * 4 + hd) * 16384;
#pragma unroll
    for (int kb = 0; kb < 4; ++kb)
#pragma unroll
      for (int i = 0; i < 16; ++i) sd[(size_t)(32 * kb + crow(i, hh)) * 128 + 32 * w + r] = St[kb][i];
  }
}

DI int queue_next(char* smem, unsigned* ctr) {
  int* slot = (int*)(smem + 73728 - 16);
  if (tid_opaque() == 0) *slot = (int)atomicAdd(ctr, 1u);
  __syncthreads();
  const int item = *slot;
  __syncthreads();
  return item;
}

DI void mixer_even_phase(const P& p, char* smem, int e) {
  unsigned* ctr = (unsigned*)(p.ws + O_BAR) + 3600 + 64 * e;
  for (;;) {
    const int qi = queue_next(smem, ctr);
    if (qi >= 320 + 1024) {
      const int ndef = (e == 0 ? NDEF0 : NDEF1);
      int dq = qi - (320 + 1024);
      if (dq >= ndef) break;
      float* smf = (float*)smem;
      int ta = deferred_task(e, dq), tb = 0;
      float va[32], vb[32];
      transpose_load(tdesc(p, ta), va);
      for (;;) {
        dq = queue_next(smem, ctr) - (320 + 1024);
        const bool hb = dq < ndef;
        tb = deferred_task(e, hb ? dq : 0);
        transpose_load(tdesc(p, tb), vb);
        transpose_finish(smf, tdesc(p, ta), va);
        if (!hb) break;
        dq = queue_next(smem, ctr) - (320 + 1024);
        const bool ha = dq < ndef;
        ta = deferred_task(e, ha ? dq : 0);
        transpose_load(tdesc(p, ta), va);
        transpose_finish(smf, tdesc(p, tb), vb);
        if (!ha) break;
      }
      break;
    }
    int item;
    if (qi < 64) item = qi;
    else if (qi < 576) item = 320 + (qi - 64);
    else if (qi < 832) item = 64 + (qi - 576);
    else item = 320 + 512 + (qi - 832);
    if (item < 320) {
      hgrn_item(smem, p, e, item);
    } else {
      AttnArgs a;
      const int q = item - 320;
      a.ldq = 512; a.PE0 = nullptr; a.PE1 = nullptr; a.ldk0 = 128; a.ldk1 = 128; a.has_sink = 1; a.scale = 0.125f;
      if (q < 512) {
        const int b = q >> 6, head = (q >> 3) & 7, qt = q & 7, kvh = head >> 2;
        const int row0 = NPR + b * 1024;
        a.Q = WSP(u16, O_QA) + (size_t)(row0 + qt * 128) * 512 + head * 64;
        a.K0 = WSP(u16, O_KA) + (size_t)row0 * 128 + kvh * 64;
        a.kb0 = qt * 128 - 128 < 0 ? 0 : qt * 128 - 128;
        a.ke0 = qt * 128 + 256 > 1024 ? 1024 : qt * 128 + 256;
        a.K1 = WSP(u16, O_KCA) + (size_t)((e * 8 + b) * 512) * 128 + kvh * 64;
        a.ke1 = 512;
        a.VT = WSP(u16, O_VTAL) + (size_t)(((e * 8 + b) * 2 + kvh) * 64) * 1536;
        a.ldvt = 1536; a.vtoff1 = 1024; a.banded = 1; a.qpos0 = qt * 128;
        a.sink = p.a_sink[e * 8 + head];
        a.O = WSP(u16, O_HM) + (size_t)(row0 + qt * 128) * 1024 + head * 64;
      } else {
        const int q2 = q - 512;
        const int b = q2 >> 4, head = (q2 >> 1) & 7, qt = q2 & 1, kvh = head >> 2;
        const int row0 = b * 256;
        a.Q = WSP(u16, O_QA) + (size_t)(row0 + qt * 128) * 512 + head * 64;
        a.K0 = WSP(u16, O_KA) + (size_t)row0 * 128 + kvh * 64;
        a.kb0 = 0; a.ke0 = 256;
        a.K1 = a.K0; a.ke1 = 0;
        a.VT = WSP(u16, O_VTAP) + (size_t)((b * 2 + kvh) * 64) * 256;
        a.ldvt = 256; a.vtoff1 = 0; a.banded = 0; a.qpos0 = 0;
        a.sink = p.a_sink[e * 8 + head];
        a.O = WSP(u16, O_HM) + (size_t)(row0 + qt * 128) * 1024 + head * 64;
      }
      attn_item<64>(smem, a);
    }
  }
}

DI void mixer_odd_phase(const P& p, char* smem, int o) {
  unsigned* ctr = (unsigned*)(p.ws + O_BAR) + 3600 + 64 * (2 + o);
  for (;;) {
    const int item = queue_next(smem, ctr);
    if (item >= 2048) break;
    AttnArgs a;
    a.has_sink = 0; a.sink = 0.f; a.banded = 0; a.qpos0 = 0; a.kb0 = 0;
    const int grp = item >> 9, q = item & 511;
    const bool lat = grp < 2, isC = (grp & 1) == 0;
    int b, head, qt, row0, nk;
    if (lat) { b = q >> 6; head = (q >> 3) & 7; qt = q & 7; row0 = NPR + b * 1024; nk = 1024; }
    else { b = q >> 4; head = (q >> 1) & 7; qt = q & 1; row0 = b * 256; nk = 256; }
    a.ke0 = nk;
    a.ke1 = lat ? 512 : 0;
    a.ldvt = lat ? 1536 : 256;
    a.vtoff1 = 1024;
    if (isC) {
      a.Q = WSP(u16, O_QC) + (size_t)(row0 + qt * 128) * 768 + head * 96; a.ldq = 768;
      a.K0 = WSP(u16, O_KN) + (size_t)row0 * 512 + head * 64; a.ldk0 = 512;
      a.PE0 = WSP(u16, O_KPE) + (size_t)row0 * 32;
      a.K1 = WSP(u16, O_KN) + (size_t)(NROWS + b * 512) * 512 + head * 64; a.ldk1 = 512;
      a.PE1 = WSP(u16, O_PECTX) + (size_t)((o * 8 + b) * 512) * 32;
      a.VT = lat ? WSP(u16, O_VTCL) + (size_t)((b * 8 + head) * 64) * 1536
                 : WSP(u16, O_VTCP) + (size_t)((b * 8 + head) * 64) * 256;
      a.scale = 0.10206207261596575f;
      a.O = WSP(u16, O_HM) + (size_t)(row0 + qt * 128) * 1024 + head * 64;
      attn_item<96>(smem, a);
    } else {
      const int kvh = head >> 1;
      a.Q = WSP(u16, O_QD) + (size_t)(row0 + qt * 128) * 512 + head * 64; a.ldq = 512;
      a.K0 = WSP(u16, O_KD) + (size_t)row0 * 256 + kvh * 64; a.ldk0 = 256;
      a.PE0 = nullptr; a.PE1 = nullptr;
      a.K1 = WSP(u16, O_KCD) + (size_t)((o * 8 + b) * 512) * 256 + kvh * 64; a.ldk1 = 256;
      a.VT = lat ? WSP(u16, O_VTDL) + (size_t)(((o * 8 + b) * 4 + kvh) * 64) * 1536
                 : WSP(u16, O_VTDP) + (size_t)((b * 4 + kvh) * 64) * 256;
      a.scale = 0.125f;
      a.O = WSP(u16, O_HM) + (size_t)(row0 + qt * 128) * 1024 + 512 + head * 64;
      attn_item<64>(smem, a);
    }
  }
}


#define XB_TMO      128
#define XB_XCNT(j)  (256  + 64 * (j))
#define XB_XSUB(j)  (1280 + 64 * (j))
#define XB_XGEN(j)  (2304 + 64 * (j))
#define XB_TOP      3328
#define XB_TOPGEN   3392
#define XCD_BAR_WORDS 3456
#define XB_SPIN_CAP (1u << 20)
#define LAS __attribute__((address_space(3)))
DI unsigned xb_ld(unsigned* q) { return __hip_atomic_load(q, __ATOMIC_RELAXED, __HIP_MEMORY_SCOPE_AGENT); }
DI unsigned xb_add(unsigned* q, unsigned v) { return __hip_atomic_fetch_add(q, v, __ATOMIC_RELAXED, __HIP_MEMORY_SCOPE_AGENT); }
DI unsigned xb_xcc_id() { return (unsigned)__builtin_amdgcn_s_getreg((3 << 11) | 20) & 0xFu; }
#define XB_SPIN(cond, bar) do { unsigned _sp = 0; while (cond) { __builtin_amdgcn_s_sleep(1); \
    if ((++_sp & 255u) == 0u) { if (xb_ld(&(bar)[XB_TMO])) break; if (_sp > XB_SPIN_CAP) { atomicAdd(&(bar)[XB_TMO], 1u); break; } } } } while (0)
struct XcdBarrier { unsigned* bar; unsigned x; volatile LAS unsigned* st; };
DI XcdBarrier xcd_barrier_post(unsigned* bar, volatile LAS unsigned* st) {
  XcdBarrier b; b.bar = bar; b.x = xb_xcc_id(); b.st = st;
  if (threadIdx.x == 0) (void)xb_add(&bar[XB_XCNT(b.x)], 1u);
  return b;
}
DI void xcd_barrier_complete(unsigned* bar, unsigned x, unsigned& nloc, unsigned& nx) {
  const unsigned G = gridDim.x * gridDim.y * gridDim.z;
  unsigned sum, cnt, mine, sp = 0u;
  for (;;) {
    sum = 0u; cnt = 0u; mine = 0u;
#pragma unroll
    for (unsigned j = 0; j < 16; ++j) { const unsigned c = xb_ld(&bar[XB_XCNT(j)]); sum += c; cnt += (c > 0u) ? 1u : 0u; mine = (j == x) ? c : mine; }
    if (sum == G) break;
    __builtin_amdgcn_s_sleep(1);
    if ((++sp & 255u) == 0u) { if (xb_ld(&bar[XB_TMO])) break; if (sp > XB_SPIN_CAP) { atomicAdd(&bar[XB_TMO], 1u); break; } }
  }
  nloc = mine > 0u ? mine : 1u; nx = cnt > 0u ? cnt : 1u;
}
DI void xcd_barrier(const XcdBarrier& b) {
  asm volatile("s_waitcnt vmcnt(0)" ::: "memory");
  __syncthreads();
  if (threadIdx.x == 0) {
    unsigned* bar = b.bar;
    __builtin_amdgcn_s_waitcnt(0);
    unsigned nloc = b.st[0], nx = b.st[1];
    if (nloc == 0u) { xcd_barrier_complete(bar, b.x, nloc, nx); b.st[0] = nloc; b.st[1] = nx; }
    const unsigned old = xb_add(&bar[XB_XSUB(b.x)], 1u);
    const unsigned gen = old / nloc;
    if (old + 1u == (gen + 1u) * nloc) {
      __builtin_amdgcn_fence(__ATOMIC_RELEASE, "agent");
      asm volatile("s_waitcnt vmcnt(0)" ::: "memory");
      const unsigned og = xb_add(&bar[XB_TOP], 1u);
      const unsigned tg = og / nx;
      if (og + 1u == (tg + 1u) * nx) xb_add(&bar[XB_TOPGEN], 1u);
      else XB_SPIN(xb_ld(&bar[XB_TOPGEN]) == tg, bar);
      __builtin_amdgcn_fence(__ATOMIC_ACQUIRE, "agent");
      xb_add(&bar[XB_XGEN(b.x)], 1u);
      asm volatile("s_waitcnt vmcnt(0)" ::: "memory");
    } else {
      XB_SPIN(xb_ld(&bar[XB_XGEN(b.x)]) == gen, bar);
      __builtin_amdgcn_fence(__ATOMIC_ACQUIRE, "agent");
      asm volatile("s_waitcnt vmcnt(0)" ::: "memory");
    }
  }
  __syncthreads();
}

constexpr int N_PHASES = 2 + 2 * 17;

__global__ void __launch_bounds__(256, 2) mega(P p, int ph_lo, int ph_hi) {
  __shared__ __attribute__((aligned(16))) char smem[73728];
  cg::grid_group grid = cg::this_grid();
  __shared__ uint4 xb_words;
  if (threadIdx.x == 0) xb_words = make_uint4(0u, 0u, 0u, 0u);
  __syncthreads();
  XcdBarrier xb = xcd_barrier_post((unsigned*)(p.ws + O_BAR), (volatile LAS unsigned*)&xb_words);
  for (int ph = ph_lo; ph < ph_hi; ++ph) {
    if (ph == 0) prep_phase(p, smem);
    else if (ph == 1) h0_phase(p);
    else {
      const int q = ph - 2, pair = q / 17, rr = q % 17;
      int l, idx;
      if (rr < 8) {
        l = 2 * pair;
        const int map[8] = {0, 3, 4, 5, 6, 7, 8, 9};
        idx = rr == 0 ? 0 : rr + 2;
        (void)map;
      } else {
        l = 2 * pair + 1;
        const int r2 = rr - 8;
        idx = r2 < 4 ? r2 : r2 + 1;
      }
      const bool even = (l & 1) == 0;
#ifdef DUPMASK
      if ((DUPMASK >> idx) & 1) {
        if (idx == 0) gemm_phase(p, smem, even ? G_EVEN_IN : G_ODD_IN, l);
        else if (idx == 2) gemm_phase(p, smem, G_UPS, l);
        else if (idx == 3) { if (even) mixer_even_phase(p, smem, l >> 1); else mixer_odd_phase(p, smem, l >> 1); }
        else if (idx == 7) gemm_phase(p, smem, G_FFNUP, l);
        xcd_barrier(xb);
      }
#endif
      if (idx == 0) gemm_phase(p, smem, even ? G_EVEN_IN : G_ODD_IN, l);
      else if (idx == 1) post_odd_phase(p, l >> 1);
      else if (idx == 2) gemm_phase(p, smem, G_UPS, l);
      else if (idx == 3) { if (even) mixer_even_phase(p, smem, l >> 1); else mixer_odd_phase(p, smem, l >> 1); }
      else if (idx == 4) hfin_phase(p, l >> 1);
      else if (idx == 5) gemm_phase(p, smem, G_OUTP, l);
      else if (idx == 6) ln_phase(p, l, 0);
      else if (idx == 7) gemm_phase(p, smem, G_FFNUP, l);
      else if (idx == 8) gemm_phase(p, smem, G_FFNDN, l);
      else ln_phase(p, l, 1);
    }
    if (ph + 1 < ph_hi) { if (ph == ph_lo) grid.sync(); else xcd_barrier(xb); }
  }
}

extern "C" void kernel_launch(void* const* d_in, const int* in_sizes, int n_in, void* d_out, int out_size, void* d_ws,
                              size_t ws_size, hipStream_t stream) {
  static int grid_blocks = 0;
  if (!grid_blocks) {
    int dev = 0, cus = 0, per_cu = 0;
    hipGetDevice(&dev);
    hipDeviceGetAttribute(&cus, hipDeviceAttributeMultiprocessorCount, dev);
    hipOccupancyMaxActiveBlocksPerMultiprocessor(&per_cu, mega, 256, 0);
    if (per_cu > 2) per_cu = 2;
    if (per_cu < 1) per_cu = 1;
    grid_blocks = (cus * per_cu) & ~7;
  }
  P p{};
  const float** pp = (const float**)&p;
  for (int i = 0; i < 30; ++i) pp[i] = (const float*)d_in[i];
  p.out = (float*)d_out;
  p.ws = (char*)d_ws;
  hipMemsetAsync((char*)d_ws + O_BAR, 0, 16384, stream);
  hipMemsetAsync((char*)d_ws + O_MOD, 0, SZ_MOD, stream);
  int lo = 0, hi = N_PHASES;
  void* args[] = {&p, &lo, &hi};
  hipError_t e = hipLaunchCooperativeKernel((void*)mega, dim3(grid_blocks), dim3(256), args, 0, stream);
  if (e != hipSuccess) fprintf(stderr, "cooperative launch failed: %s (grid %d)\n", hipGetErrorString(e), grid_blocks);
}
```

```cpp
#include <hip/hip_runtime.h>
#include <hip/hip_cooperative_groups.h>
#include <cstdio>
namespace cg = cooperative_groups;

typedef unsigned short u16;
typedef short bf16x8 __attribute__((ext_vector_type(8)));
typedef short s16x4 __attribute__((ext_vector_type(4)));
typedef float f32x16 __attribute__((ext_vector_type(16)));
typedef float f32x4 __attribute__((ext_vector_type(4)));
typedef unsigned u32x4 __attribute__((ext_vector_type(4)));
typedef unsigned u32x2 __attribute__((ext_vector_type(2)));

#define DI __device__ __forceinline__
#define SB()
#define MFMA(a, b, c) __builtin_amdgcn_mfma_f32_32x32x16_bf16((a), (b), (c), 0, 0, 0)

constexpr int NROWS = 16384;
constexpr int NPR = 8192;
constexpr float ALPHA_F = 1.681792830507429f;
constexpr float LOG2E = 1.4426950408889634f;

constexpr size_t OUT_AK = 16777216, OUT_AV = 18874368, OUT_SB = 20971520, OUT_CKV = 29360128,
                 OUT_CPE = 33554432, OUT_DK = 34078720, OUT_DV = 38273024;

constexpr size_t SZ_WAB = 2ull * 3328 * 1024 * 2, SZ_WCD = 2ull * 1792 * 1024 * 2, SZ_WQU = 2ull * 768 * 384 * 2,
                 SZ_WKVU = 2ull * 1024 * 256 * 2, SZ_WO = 4ull * 1024 * 1024 * 2, SZ_WGU = 4ull * 5632 * 1024 * 2,
                 SZ_WD = 4ull * 1024 * 2816 * 2;
constexpr size_t O_WAB = 0, O_WCD = O_WAB + SZ_WAB, O_WQU = O_WCD + SZ_WCD, O_WKVU = O_WQU + SZ_WQU,
                 O_WO = O_WKVU + SZ_WKVU, O_WGU = O_WO + SZ_WO, O_WD = O_WGU + SZ_WGU, O_MOD = O_WD + SZ_WD;
constexpr size_t SZ_MOD = 4ull * 9 * 6144 * 4;
constexpr size_t O_CS64 = O_MOD + SZ_MOD;
constexpr size_t O_CS32 = O_CS64 + 64 * 16 * 2 * 4;
constexpr size_t O_LBT = O_CS32 + 64 * 8 * 2 * 4;
constexpr size_t O_HM = O_LBT + 2 * 2 * 512 * 4;
constexpr size_t O_R1 = O_HM + 16384ull * 1024 * 2;
constexpr size_t O_QA = O_R1, O_KA = O_QA + 16384ull * 512 * 2, O_QB = O_KA + 16384ull * 128 * 2,
                 O_IB = O_QB + 16384ull * 512 * 2, O_GB = O_IB + 16384ull * 512 * 2, O_FF = O_GB + 16384ull * 512 * 2,
                 O_FB = O_FF + 16384ull * 512 * 4, O_R1E_END = O_FB + 16384ull * 512 * 4;
constexpr size_t O_PROJ = O_R1, O_CKVN = O_PROJ + 16384ull * 1792 * 2, O_KPE = O_CKVN + 20480ull * 256 * 2,
                 O_QD = O_KPE + 16384ull * 32 * 2, O_KD = O_QD + 16384ull * 512 * 2, O_QC = O_KD + 16384ull * 256 * 2,
                 O_KN = O_QC + 16384ull * 768 * 2, O_RCQ = O_KN + 20480ull * 512 * 2, O_R1O_END = O_RCQ + 16384 * 4;
constexpr size_t O_ACT = O_R1;
constexpr size_t SZ_R1 = (O_R1O_END > O_R1E_END ? O_R1O_END : O_R1E_END) - O_R1;
constexpr size_t O_OFB = O_R1 + SZ_R1;
constexpr size_t O_VTAP = O_OFB + 2ull * 16384 * 512 * 4;
constexpr size_t O_VTAL = O_VTAP + 32ull * 2 * 64 * 256 * 2;
constexpr size_t O_KCA = O_VTAL + 2ull * 8 * 2 * 64 * 1536 * 2;
constexpr size_t O_VTDP = O_KCA + 2ull * 8 * 512 * 128 * 2;
constexpr size_t O_VTDL = O_VTDP + 32ull * 4 * 64 * 256 * 2;
constexpr size_t O_KCD = O_VTDL + 2ull * 8 * 4 * 64 * 1536 * 2;
constexpr size_t O_VTCP = O_KCD + 2ull * 8 * 512 * 256 * 2;
constexpr size_t O_VTCL = O_VTCP + 32ull * 8 * 64 * 256 * 2;
constexpr size_t O_PECTX = O_VTCL + 8ull * 8 * 64 * 1536 * 2;
constexpr size_t WS_TOTAL = O_PECTX + 2ull * 8 * 512 * 32 * 2;
constexpr size_t O_BAR = (WS_TOTAL + 255) & ~(size_t)255;
constexpr size_t O_ST = O_BAR + 16384;
static_assert(O_ST + 16384 * 8 < 411000000ull, "workspace too large");
static_assert(16384ull * 2816 * 2 <= SZ_R1, "ACT must fit R1");

struct P {
  const float *x_prompt, *x_sample, *cache_a_k, *cache_a_v, *state_b, *cache_c_kv, *cache_c_pe, *cache_d_k, *cache_d_v,
      *c, *c_ctx, *w_ada, *b_ada, *ln_g, *ln_b, *w_in_ab, *a_sink, *b_lb, *b_gnorm, *w_in_cd, *c_q_norm, *c_kv_norm,
      *c_w_q_up, *c_w_kv_up, *d_q_norm, *d_k_norm, *w_out, *w_ffn_gate, *w_ffn_up, *w_ffn_down;
  float* out;
  char* ws;
};

DI float bf2f(u16 v) { return __uint_as_float(((unsigned)v) << 16); }
typedef __bf16 bf16v2 __attribute__((ext_vector_type(2)));
typedef float f32v2 __attribute__((ext_vector_type(2)));
DI unsigned pack2(float a, float b) {
  f32v2 v;
  v[0] = a;
  v[1] = b;
  return __builtin_bit_cast(unsigned, __builtin_convertvector(v, bf16v2));
}
DI u16 f2bf(float x) { return (u16)(pack2(x, x) & 0xffffu); }
DI int crow(int i, int h) { return (i & 3) + 8 * (i >> 2) + 4 * h; }
DI float silu_f(float x) { return x * __builtin_amdgcn_rcpf(1.f + __expf(-x)); }
DI float sigmoid_f(float x) { return __builtin_amdgcn_rcpf(1.f + __expf(-x)); }
DI int mod_index(int R) { return R < NPR ? 0 : 1 + ((R - NPR) >> 10); }
DI float xhalf_max(float x) {
  auto r = __builtin_amdgcn_permlane32_swap(__float_as_uint(x), __float_as_uint(x), false, false);
  return fmaxf(__uint_as_float(r[0]), __uint_as_float(r[1]));
}
DI float xhalf_sum(float x) {
  auto r = __builtin_amdgcn_permlane32_swap(__float_as_uint(x), __float_as_uint(x), false, false);
  return __uint_as_float(r[0]) + __uint_as_float(r[1]);
}
DI float wave_sum(float v) {
#pragma unroll
  for (int o = 32; o >= 1; o >>= 1) v += __shfl_xor(v, o);
  return v;
}
template <int S>
DI bf16x8 pack8(const f32x16& x) {
  u32x4 p;
  p[0] = pack2(x[8 * S + 0], x[8 * S + 1]);
  p[1] = pack2(x[8 * S + 2], x[8 * S + 3]);
  p[2] = pack2(x[8 * S + 4], x[8 * S + 5]);
  p[3] = pack2(x[8 * S + 6], x[8 * S + 7]);
  return __builtin_bit_cast(bf16x8, p);
}
DI bf16x8 cat4(s16x4 lo, s16x4 hi) { return __builtin_shufflevector(lo, hi, 0, 1, 2, 3, 4, 5, 6, 7); }
DI f32x16 zero16() {
  f32x16 z;
#pragma unroll
  for (int i = 0; i < 16; ++i) z[i] = 0.f;
  return z;
}

DI int tid_opaque() { int x = threadIdx.x; asm volatile("" : "+v"(x)); return x; }
DI int bid_opaque() { int x = blockIdx.x; asm volatile("" : "+s"(x)); return x; }
DI void st_u16(void* base, unsigned boff, u16 v) { *(u16*)((char*)base + boff) = v; }
DI void st_f32(void* base, unsigned boff, float v) { *(float*)((char*)base + boff) = v; }
#define WSP(T, off) ((T*)(p.ws + (off)))

struct TDesc { const float* g0; const float* g1; const float* kscale; u16* dst; int ld_src, kind, k0, n0, ld_dst, pad_; };

DI void transpose_load(const TDesc d, float (&v)[32]) {
  const int t = tid_opaque();
  const int n = t & 127, kh = t >> 7;
  const int nd = d.n0 + n;
  const float* src = nullptr;
  if (d.kind == 0) src = d.g0 + nd;
  else if (d.kind == 1) {
    if (nd < 640) src = d.g0 + nd;
    else if (nd < 1664) src = d.g0 + nd + 32;
    else if (nd < 1696) src = d.g0 + nd - 1024;
  } else {
    const int which = (nd >> 5) & 1, j = (nd >> 6) * 32 + (nd & 31);
    src = (which ? d.g1 : d.g0) + j;
  }
#pragma unroll
  for (int i = 0; i < 32; ++i) v[i] = src ? __builtin_nontemporal_load(src + (size_t)(d.k0 + kh + 2 * i) * d.ld_src) : 0.f;
}
DI void transpose_finish(float* sm, const TDesc d, const float (&v)[32]) {
  const int t = tid_opaque();
  {
    const int n = t & 127, kh = t >> 7;
#pragma unroll
    for (int i = 0; i < 32; ++i) {
      const int k = kh + 2 * i;
      sm[k * 129 + n] = d.kscale ? v[i] * d.kscale[d.k0 + k] : v[i];
    }
  }
  __syncthreads();
#pragma unroll
  for (int j = 0; j < 4; ++j) {
    const int c = t + 256 * j, n = c >> 3, kc = c & 7;
    u32x4 o;
#pragma unroll
    for (int q = 0; q < 4; ++q) o[q] = pack2(sm[(kc * 8 + 2 * q) * 129 + n], sm[(kc * 8 + 2 * q + 1) * 129 + n]);
    *(u32x4*)(d.dst + (size_t)(d.n0 + n) * d.ld_dst + d.k0 + kc * 8) = o;
  }
  __syncthreads();
}

constexpr int T_AB = 416, T_CD = 224, T_QU = 36, T_KVU = 32, T_O = 128, T_GU = 704, T_D = 352;
constexpr int E_AB = 2 * T_AB, E_CD = E_AB + 2 * T_CD, E_QU = E_CD + 2 * T_QU, E_KVU = E_QU + 2 * T_KVU,
              E_O = E_KVU + 4 * T_O, E_GU = E_O + 4 * T_GU, E_D = E_GU + 4 * T_D;

DI TDesc tdesc(const P& p, int task) {
  TDesc d;
  d.g1 = nullptr; d.kscale = nullptr; d.kind = 0; d.pad_ = 0;
  if (task < E_AB) {
    const int e = task / T_AB, r = task % T_AB, kt = r / 26, nt = r % 26;
    d.g0 = p.w_in_ab + (size_t)e * 1024 * 3328; d.ld_src = 3328; d.k0 = kt * 64; d.n0 = nt * 128;
    d.dst = WSP(u16, O_WAB) + (size_t)e * 3328 * 1024; d.ld_dst = 1024;
  } else if (task < E_CD) {
    const int q = task - E_AB, o = q / T_CD, r = q % T_CD, kt = r / 14, nt = r % 14;
    d.g0 = p.w_in_cd + (size_t)o * 1024 * 1696; d.ld_src = 1696; d.kind = 1; d.k0 = kt * 64; d.n0 = nt * 128;
    d.dst = WSP(u16, O_WCD) + (size_t)o * 1792 * 1024; d.ld_dst = 1024;
  } else if (task < E_QU) {
    const int q = task - E_CD, o = q / T_QU, r = q % T_QU, kt = r / 6, nt = r % 6;
    d.g0 = p.c_w_q_up + (size_t)o * 384 * 768; d.ld_src = 768; d.k0 = kt * 64; d.n0 = nt * 128;
    d.dst = WSP(u16, O_WQU) + (size_t)o * 768 * 384; d.ld_dst = 384; d.kscale = p.c_q_norm + o * 384;
  } else if (task < E_KVU) {
    const int q = task - E_QU, o = q / T_KVU, r = q % T_KVU, kt = r / 8, nt = r % 8;
    d.g0 = p.c_w_kv_up + (size_t)o * 256 * 1024; d.ld_src = 1024; d.k0 = kt * 64; d.n0 = nt * 128;
    d.dst = WSP(u16, O_WKVU) + (size_t)o * 1024 * 256; d.ld_dst = 256;
  } else if (task < E_O) {
    const int q = task - E_KVU, l = q / T_O, r = q % T_O, kt = r / 8, nt = r % 8;
    d.g0 = p.w_out + (size_t)l * 1024 * 1024; d.ld_src = 1024; d.k0 = kt * 64; d.n0 = nt * 128;
    d.dst = WSP(u16, O_WO) + (size_t)l * 1024 * 1024; d.ld_dst = 1024;
  } else if (task < E_GU) {
    const int q = task - E_O, l = q / T_GU, r = q % T_GU, kt = r / 44, nt = r % 44;
    d.g0 = p.w_ffn_gate + (size_t)l * 1024 * 2816; d.g1 = p.w_ffn_up + (size_t)l * 1024 * 2816; d.ld_src = 2816; d.kind = 2;
    d.k0 = kt * 64; d.n0 = nt * 128; d.dst = WSP(u16, O_WGU) + (size_t)l * 5632 * 1024; d.ld_dst = 1024;
  } else {
    const int q = task - E_GU, l = q / T_D, r = q % T_D, kt = r / 8, nt = r % 8;
    d.g0 = p.w_ffn_down + (size_t)l * 2816 * 1024; d.ld_src = 1024; d.k0 = kt * 64; d.n0 = nt * 128;
    d.dst = WSP(u16, O_WD) + (size_t)l * 1024 * 2816; d.ld_dst = 2816;
  }
  return d;
}
DI void transpose_task(const P& p, float* sm, int task) {
  const TDesc d = tdesc(p, task);
  float v[32];
  transpose_load(d, v);
  transpose_finish(sm, d, v);
}

constexpr int NDEF0 = 2 * (T_O + T_GU + T_D) + T_CD + T_QU + T_KVU + T_AB, NDEF1 = NDEF0 - T_AB;
DI int deferred_task(int e, int q) {
  const int l0 = 2 * e;
  if (q < T_O) return E_KVU + l0 * T_O + q;
  q -= T_O;
  if (q < T_GU) return E_O + l0 * T_GU + q;
  q -= T_GU;
  if (q < T_D) return E_GU + l0 * T_D + q;
  q -= T_D;
  if (q < T_CD) return E_AB + e * T_CD + q;
  q -= T_CD;
  if (q < T_QU) return E_CD + e * T_QU + q;
  q -= T_QU;
  if (q < T_KVU) return E_QU + e * T_KVU + q;
  q -= T_KVU;
  if (q < T_O) return E_KVU + (l0 + 1) * T_O + q;
  q -= T_O;
  if (q < T_GU) return E_O + (l0 + 1) * T_GU + q;
  q -= T_GU;
  if (q < T_D) return E_GU + (l0 + 1) * T_D + q;
  q -= T_D;
  return T_AB + q;
}

DI void prep_phase(const P& p, char* smem) {
  float* sm = (float*)smem;
  const int t = tid_opaque();
  for (int task0 = bid_opaque(); task0 < 768 + T_AB; task0 += gridDim.x) {
    if (task0 >= 768) {
      transpose_task(p, sm, task0 - 768);
    } else {
      const int l = task0 / 192, rem = task0 % 192, cb = rem >> 1, kh = rem & 1;
      float* sc = sm;
      float* red = sm + 9 * 512;
      for (int idx = t; idx < 4608; idx += 256) {
        const int m = idx >> 9, k = kh * 512 + (idx & 511);
        const float cv = (m == 0) ? p.c_ctx[k] : p.c[(m - 1) * 1024 + k];
        sc[idx] = silu_f(cv);
      }
      __syncthreads();
      const int cc = t & 63, kq = t >> 6;
      const float* w = p.w_ada + ((size_t)l * 1024 + kh * 512 + kq * 128) * 6144 + cb * 64 + cc;
      float acc[9];
#pragma unroll
      for (int m = 0; m < 9; ++m) acc[m] = 0.f;
#pragma unroll 16
      for (int k = 0; k < 128; ++k) {
        const float wv = __builtin_nontemporal_load(w + (size_t)k * 6144);
#pragma unroll
        for (int m = 0; m < 9; ++m) acc[m] += sc[m * 512 + kq * 128 + k] * wv;
      }
#pragma unroll
      for (int m = 0; m < 9; ++m) red[(kq * 9 + m) * 64 + cc] = acc[m];
      __syncthreads();
      for (int idx = t; idx < 576; idx += 256) {
        const int m = idx >> 6, c2 = idx & 63;
        float s2 = red[(0 * 9 + m) * 64 + c2] + red[(1 * 9 + m) * 64 + c2] + red[(2 * 9 + m) * 64 + c2] +
                   red[(3 * 9 + m) * 64 + c2];
        if (kh == 0) s2 += p.b_ada[l * 6144 + cb * 64 + c2];
        atomicAdd(WSP(float, O_MOD) + ((size_t)l * 9 + m) * 6144 + cb * 64 + c2, s2);
      }
      __syncthreads();
    }
  }
  const int gt = bid_opaque() * 256 + t, ngt = gridDim.x * 256;
  for (int i = gt; i < 64 * 16; i += ngt) {
    const int pos = i >> 4, j = i & 15;
    const float inv = powf(10000.f, -(float)j / 16.f);
    const float a = (float)pos * inv;
    WSP(float, O_CS64)[2 * i] = cosf(a);
    WSP(float, O_CS64)[2 * i + 1] = sinf(a);
  }
  for (int i = gt; i < 64 * 8; i += ngt) {
    const int pos = i >> 3, j = i & 7;
    const float inv = powf(10000.f, -(float)j / 8.f);
    const float a = (float)pos * inv;
    WSP(float, O_CS32)[2 * i] = cosf(a);
    WSP(float, O_CS32)[2 * i + 1] = sinf(a);
  }
  for (int i = gt; i < 2048; i += ngt) {
    const int e = i >> 10, r = i & 1023;
    float v = 0.f;
    if (e == 1) v = 1.f / (1.f + expf(p.b_lb[r] - p.b_lb[1024 + r]));
    WSP(float, O_LBT)[i] = v;
  }
  for (int i4 = gt; i4 < 2 * 8 * 512 * 32; i4 += ngt) {
    const int i = i4 * 4;
    const int c = i & 127, pp = (i >> 7) & 511, b = (i >> 16) & 7, e = i >> 19;
    const f32x4 v = *(const f32x4*)(p.cache_a_k + (((size_t)b * 2 + e) * 512 + pp) * 128 + c);
    u32x2 o;
    o[0] = pack2(v[0], v[1]);
    o[1] = pack2(v[2], v[3]);
    *(u32x2*)(WSP(u16, O_KCA) + i) = o;
  }
  for (int i = gt; i < 2 * 8 * 64 * 128; i += ngt) {
    const int c = i & 127, pc = (i >> 7) & 63, b = (i >> 13) & 7, e = i >> 16;
    const float* src = p.cache_a_v + (((size_t)b * 2 + e) * 512 + pc * 8) * 128 + c;
    u32x4 o;
#pragma unroll
    for (int q = 0; q < 4; ++q) o[q] = pack2(src[(2 * q) * 128], src[(2 * q + 1) * 128]);
    *(u32x4*)(WSP(u16, O_VTAL) + ((size_t)((e * 8 + b) * 2 + (c >> 6)) * 64 + (c & 63)) * 1536 + 1024 + pc * 8) = o;
  }
  for (int i4 = gt; i4 < 2 * 8 * 512 * 64; i4 += ngt) {
    const int i = i4 * 4;
    const int c = i & 255, pp = (i >> 8) & 511, b = (i >> 17) & 7, o = i >> 20;
    const f32x4 v = *(const f32x4*)(p.cache_d_k + (((size_t)b * 2 + o) * 512 + pp) * 256 + c);
    u32x2 ov;
    ov[0] = pack2(v[0], v[1]);
    ov[1] = pack2(v[2], v[3]);
    *(u32x2*)(WSP(u16, O_KCD) + i) = ov;
  }
  for (int i = gt; i < 2 * 8 * 64 * 256; i += ngt) {
    const int c = i & 255, pc = (i >> 8) & 63, b = (i >> 14) & 7, o = i >> 17;
    const float* src = p.cache_d_v + (((size_t)b * 2 + o) * 512 + pc * 8) * 256 + c;
    u32x4 ov;
#pragma unroll
    for (int q = 0; q < 4; ++q) ov[q] = pack2(src[(2 * q) * 256], src[(2 * q + 1) * 256]);
    *(u32x4*)(WSP(u16, O_VTDL) + ((size_t)((o * 8 + b) * 4 + (c >> 6)) * 64 + (c & 63)) * 1536 + 1024 + pc * 8) = ov;
  }
  for (int i4 = gt; i4 < 2 * 8 * 512 * 8; i4 += ngt) {
    const int i = i4 * 4;
    const int c = i & 31, pp = (i >> 5) & 511, b = (i >> 14) & 7, o = i >> 17;
    const f32x4 v = *(const f32x4*)(p.cache_c_pe + (((size_t)b * 2 + o) * 512 + pp) * 32 + c);
    u32x2 ov;
    ov[0] = pack2(v[0], v[1]);
    ov[1] = pack2(v[2], v[3]);
    *(u32x2*)(WSP(u16, O_PECTX) + i) = ov;
  }
}

DI const float* x_input_row(const P& p, int R) {
  return R < NPR ? p.x_prompt + (size_t)R * 1024 : p.x_sample + (size_t)(R - NPR) * 1024;
}

DI void h0_phase(const P& p) {
  const int lane = tid_opaque() & 63;
  const int gw = bid_opaque() * 4 + (tid_opaque() >> 6), nw = gridDim.x * 4;
  for (int R0 = gw * 4; R0 < NROWS; R0 += nw * 4) {
    const float* md = WSP(float, O_MOD) + (size_t)(0 * 9 + mod_index(R0)) * 6144;
    f32x4 v[4][4];
#pragma unroll
    for (int rr = 0; rr < 4; ++rr) {
      const float* xr = x_input_row(p, R0 + rr);
#pragma unroll
      for (int j = 0; j < 4; ++j) v[rr][j] = *(const f32x4*)(xr + j * 256 + lane * 4);
    }
#pragma unroll
    for (int j = 0; j < 4; ++j) {
      const int c = j * 256 + lane * 4;
      const f32x4 sh = *(const f32x4*)(md + c), scl = *(const f32x4*)(md + 1024 + c);
#pragma unroll
      for (int rr = 0; rr < 4; ++rr) {
        u32x2 o;
        o[0] = pack2(v[rr][j][0] * (1.f + scl[0]) + sh[0], v[rr][j][1] * (1.f + scl[1]) + sh[1]);
        o[1] = pack2(v[rr][j][2] * (1.f + scl[2]) + sh[2], v[rr][j][3] * (1.f + scl[3]) + sh[3]);
        *(u32x2*)(WSP(u16, O_HM) + (size_t)(R0 + rr) * 1024 + c) = o;
      }
    }
  }
}

DI void ln_phase(const P& p, int l, int which) {
  const int lane = tid_opaque() & 63;
  const int gw = bid_opaque() * 4 + (tid_opaque() >> 6), nw = gridDim.x * 4;
  const float* g = p.ln_g + (l * 2 + which) * 1024;
  const float* bb = p.ln_b + (l * 2 + which) * 1024;
  const bool has_h = (which == 0) || (l < 3);
  const bool full = !has_h;
  const int ml = (which == 0) ? l : l + 1;
  const int so = (which == 0) ? 3 : 0;
  for (int R0 = gw * 4; R0 < NROWS; R0 += nw * 4) {
    f32x4 v[4][4];
    float s[4], q[4], mean[4], rs[4];
#pragma unroll
    for (int rr = 0; rr < 4; ++rr) {
      const float* xr = p.out + (size_t)(R0 + rr) * 1024;
#pragma unroll
      for (int j = 0; j < 4; ++j) v[rr][j] = *(const f32x4*)(xr + j * 256 + lane * 4);
    }
#pragma unroll
    for (int rr = 0; rr < 4; ++rr) {
      s[rr] = 0.f;
#pragma unroll
      for (int j = 0; j < 4; ++j) s[rr] += v[rr][j][0] + v[rr][j][1] + v[rr][j][2] + v[rr][j][3];
    }
#pragma unroll
    for (int o = 32; o >= 1; o >>= 1)
#pragma unroll
      for (int rr = 0; rr < 4; ++rr) s[rr] += __shfl_xor(s[rr], o);
#pragma unroll
    for (int rr = 0; rr < 4; ++rr) {
      mean[rr] = s[rr] * (1.f / 1024.f);
      q[rr] = 0.f;
#pragma unroll
      for (int j = 0; j < 4; ++j)
#pragma unroll
        for (int k = 0; k < 4; ++k) {
          v[rr][j][k] -= mean[rr];
          q[rr] += v[rr][j][k] * v[rr][j][k];
        }
    }
#pragma unroll
    for (int o = 32; o >= 1; o >>= 1)
#pragma unroll
      for (int rr = 0; rr < 4; ++rr) q[rr] += __shfl_xor(q[rr], o);
#pragma unroll
    for (int rr = 0; rr < 4; ++rr) rs[rr] = rsqrtf(q[rr] * (1.f / 1024.f) + 1e-5f);
    if (!full && lane < 4) {
      f32v2 st;
      st[0] = lane == 0 ? mean[0] : lane == 1 ? mean[1] : lane == 2 ? mean[2] : mean[3];
      st[1] = lane == 0 ? rs[0] : lane == 1 ? rs[1] : lane == 2 ? rs[2] : rs[3];
      *(f32v2*)(WSP(float, O_ST) + (size_t)(R0 + lane) * 2) = st;
    }
    const float* md = WSP(float, O_MOD) + (size_t)((has_h ? ml : 0) * 9 + mod_index(R0)) * 6144;
#pragma unroll
    for (int j = 0; j < 4; ++j) {
      const int c = j * 256 + lane * 4;
      const f32x4 gg = *(const f32x4*)(g + c), bv = *(const f32x4*)(bb + c);
      f32x4 sh, scl;
      if (has_h) {
        sh = *(const f32x4*)(md + so * 1024 + c);
        scl = *(const f32x4*)(md + (so + 1) * 1024 + c);
      }
#pragma unroll
      for (int rr = 0; rr < 4; ++rr) {
        f32x4 x;
#pragma unroll
        for (int k = 0; k < 4; ++k) x[k] = v[rr][j][k] * rs[rr] * gg[k] + bv[k];
        if (full) *(f32x4*)(p.out + (size_t)(R0 + rr) * 1024 + c) = x;
        if (has_h) {
          u32x2 o;
          o[0] = pack2(x[0] * (1.f + scl[0]) + sh[0], x[1] * (1.f + scl[1]) + sh[1]);
          o[1] = pack2(x[2] * (1.f + scl[2]) + sh[2], x[3] * (1.f + scl[3]) + sh[3]);
          *(u32x2*)(WSP(u16, O_HM) + (size_t)(R0 + rr) * 1024 + c) = o;
        }
      }
    }
  }
}

DI void hfin_phase(const P& p, int e) {
  const int lane = tid_opaque() & 63;
  const int gw = bid_opaque() * 4 + (tid_opaque() >> 6), nw = gridDim.x * 4;
  const float* of = WSP(float, O_OFB);
  const float* ob = of + (size_t)NROWS * 512;
  const float* gn = p.b_gnorm + e * 128;
  for (int R = gw; R < NROWS; R += nw) {
    const int c = lane * 8;
    float o[8];
    float ss = 0.f;
#pragma unroll
    for (int j = 0; j < 2; ++j) {
      const f32x4 a = *(const f32x4*)(of + (size_t)R * 512 + c + 4 * j);
      const f32x4 b = *(const f32x4*)(ob + (size_t)R * 512 + c + 4 * j);
#pragma unroll
      for (int k = 0; k < 4; ++k) {
        o[4 * j + k] = a[k] + b[k];
        ss += o[4 * j + k] * o[4 * j + k];
      }
    }
    ss += __shfl_xor(ss, 1);
    ss += __shfl_xor(ss, 2);
    ss += __shfl_xor(ss, 4);
    ss += __shfl_xor(ss, 8);
    const float r = rsqrtf(ss * (1.f / 128.f) + 1e-6f);
    const u32x4 gbv = *(const u32x4*)(WSP(u16, O_GB) + (size_t)R * 512 + c);
    const int v0 = c & 127;
    u32x4 outv;
#pragma unroll
    for (int q = 0; q < 4; ++q) {
      const float g0 = bf2f((u16)(gbv[q] & 0xffff)), g1 = bf2f((u16)(gbv[q] >> 16));
      outv[q] = pack2(o[2 * q] * r * gn[v0 + 2 * q] * g0, o[2 * q + 1] * r * gn[v0 + 2 * q + 1] * g1);
    }
    *(u32x4*)(WSP(u16, O_HM) + (size_t)R * 1024 + 512 + c) = outv;
  }
}

DI void post_odd_phase(const P& p, int o) {
  const int lane = tid_opaque() & 63;
  const int gw = bid_opaque() * 4 + (tid_opaque() >> 6), nw = gridDim.x * 4;
  const float* cs64 = WSP(float, O_CS64);
  const float* cs32 = WSP(float, O_CS32);
  u16 rcq[6], rkpe;
  u32x2 rckv, rkd;
  u32x4 rqd;
#define POST_LOAD(RR)                                                        \
  {                                                                          \
    const u16* pr_ = WSP(u16, O_PROJ) + (size_t)(RR) * 1792;                 \
    _Pragma("unroll") for (int j = 0; j < 6; ++j) rcq[j] = pr_[lane + 64 * j]; \
    rckv = *(const u32x2*)(pr_ + 384 + lane * 4);                            \
    rqd = *(const u32x4*)(pr_ + 640 + lane * 8);                             \
    rkd = *(const u32x2*)(pr_ + 1152 + lane * 4);                            \
    rkpe = pr_[1664 + (lane & 31)];                                          \
  }
  if (gw < NROWS) POST_LOAD(gw)
  for (int R = gw; R < NROWS; R += nw) {
    u16 ccq[6];
#pragma unroll
    for (int j = 0; j < 6; ++j) ccq[j] = rcq[j];
    const u32x2 cckv = rckv, ckd = rkd;
    const u32x4 cqd = rqd;
    const u16 ckpe = rkpe;
    { const int Rn = R + nw < NROWS ? R + nw : R; POST_LOAD(Rn) }
    const bool lat = R >= NPR;
    const int b = lat ? (R - NPR) >> 10 : R >> 8;
    const int tk = lat ? (R - NPR) & 1023 : R & 255;
    const int prow = tk >> 6, pcol = tk & 63;
    {
      float ss = 0.f;
#pragma unroll
      for (int j = 0; j < 6; ++j) {
        const float v = bf2f(ccq[j]);
        ss += v * v;
      }
      ss = wave_sum(ss);
      if (lane == 0) WSP(float, O_RCQ)[R] = rsqrtf(ss * (1.f / 384.f) + 1e-6f);
    }
    {
      const u32x2 raw = cckv;
      float v[4] = {bf2f((u16)(raw[0] & 0xffff)), bf2f((u16)(raw[0] >> 16)), bf2f((u16)(raw[1] & 0xffff)),
                    bf2f((u16)(raw[1] >> 16))};
      float ss = v[0] * v[0] + v[1] * v[1] + v[2] * v[2] + v[3] * v[3];
      ss = wave_sum(ss);
      const float r = rsqrtf(ss * (1.f / 256.f) + 1e-6f);
      const f32x4 g = *(const f32x4*)(p.c_kv_norm + o * 256 + lane * 4);
      f32x4 y;
#pragma unroll
      for (int k = 0; k < 4; ++k) y[k] = v[k] * r * g[k];
      u32x2 ov;
      ov[0] = pack2(y[0], y[1]);
      ov[1] = pack2(y[2], y[3]);
      *(u32x2*)(WSP(u16, O_CKVN) + (size_t)R * 256 + lane * 4) = ov;
      if (!lat) *(f32x4*)(p.out + OUT_CKV + (((size_t)b * 2 + o) * 256 + tk) * 256 + lane * 4) = y;
    }
    {
      const u32x4 raw = cqd;
      float v[8];
#pragma unroll
      for (int q = 0; q < 4; ++q) {
        v[2 * q] = bf2f((u16)(raw[q] & 0xffff));
        v[2 * q + 1] = bf2f((u16)(raw[q] >> 16));
      }
      float ss = 0.f;
#pragma unroll
      for (int k = 0; k < 8; ++k) ss += v[k] * v[k];
      ss += __shfl_xor(ss, 1);
      ss += __shfl_xor(ss, 2);
      ss += __shfl_xor(ss, 4);
      const float r = rsqrtf(ss * (1.f / 64.f) + 1e-6f);
      const int l8 = lane & 7;
#pragma unroll
      for (int k = 0; k < 8; ++k) v[k] = v[k] * r * p.d_q_norm[o * 64 + l8 * 8 + k];
      const bool first = (l8 & 2) == 0;
      const int pos = (l8 < 4) ? prow : pcol;
      u32x4 ov;
      float y[8];
#pragma unroll
      for (int k = 0; k < 8; ++k) {
        const float pv = __shfl_xor(v[k], 2);
        const int i = (l8 & 1) * 8 + k;
        const float cc = cs64[(pos * 16 + i) * 2], sn = cs64[(pos * 16 + i) * 2 + 1];
        const float rot = first ? v[k] * cc - pv * sn : v[k] * cc + pv * sn;
        y[k] = lat ? rot : v[k];
      }
#pragma unroll
      for (int q = 0; q < 4; ++q) ov[q] = pack2(y[2 * q], y[2 * q + 1]);
      *(u32x4*)(WSP(u16, O_QD) + (size_t)R * 512 + lane * 8) = ov;
    }
    {
      const u32x2 raw = ckd;
      float v[4] = {bf2f((u16)(raw[0] & 0xffff)), bf2f((u16)(raw[0] >> 16)), bf2f((u16)(raw[1] & 0xffff)),
                    bf2f((u16)(raw[1] >> 16))};
      float ss = v[0] * v[0] + v[1] * v[1] + v[2] * v[2] + v[3] * v[3];
      ss += __shfl_xor(ss, 1);
      ss += __shfl_xor(ss, 2);
      ss += __shfl_xor(ss, 4);
      ss += __shfl_xor(ss, 8);
      const float r = rsqrtf(ss * (1.f / 64.f) + 1e-6f);
      const int l16 = lane & 15;
      f32x4 y;
#pragma unroll
      for (int k = 0; k < 4; ++k) y[k] = v[k] * r * p.d_k_norm[o * 64 + l16 * 4 + k];
      if (!lat) *(f32x4*)(p.out + OUT_DK + (((size_t)b * 2 + o) * 256 + tk) * 256 + lane * 4) = y;
      const bool first = (l16 & 4) == 0;
      const int pos = (l16 < 8) ? prow : pcol;
      float z[4];
#pragma unroll
      for (int k = 0; k < 4; ++k) {
        const float pv = __shfl_xor(y[k], 4);
        const int i = (l16 & 3) * 4 + k;
        const float cc = cs64[(pos * 16 + i) * 2], sn = cs64[(pos * 16 + i) * 2 + 1];
        const float rot = first ? y[k] * cc - pv * sn : y[k] * cc + pv * sn;
        z[k] = lat ? rot : y[k];
      }
      u32x2 ov;
      ov[0] = pack2(z[0], z[1]);
      ov[1] = pack2(z[2], z[3]);
      *(u32x2*)(WSP(u16, O_KD) + (size_t)R * 256 + lane * 4) = ov;
    }
    {
      const float v = bf2f(ckpe);
      const float pv = __shfl_xor(v, 8);
      const int l32 = lane & 31;
      const bool first = (l32 & 8) == 0;
      const int pos = (l32 < 16) ? prow : pcol;
      const int i = l32 & 7;
      const float cc = cs32[(pos * 8 + i) * 2], sn = cs32[(pos * 8 + i) * 2 + 1];
      const float rot = first ? v * cc - pv * sn : v * cc + pv * sn;
      if (lane < 32) {
        WSP(u16, O_KPE)[(size_t)R * 32 + lane] = f2bf(lat ? rot : v);
        if (!lat) p.out[OUT_CPE + (((size_t)b * 2 + o) * 256 + tk) * 32 + lane] = v;
      }
    }
  }
#undef POST_LOAD
  const int gt = bid_opaque() * 256 + tid_opaque(), ngt = gridDim.x * 256;
  for (int i4 = gt; i4 < 8 * 512 * 64; i4 += ngt) {
    const int i = i4 * 4;
    const int c = i & 255, pp = (i >> 8) & 511, b = i >> 17;
    const f32x4 v = *(const f32x4*)(p.cache_c_kv + (((size_t)b * 2 + o) * 512 + pp) * 256 + c);
    u32x2 ov;
    ov[0] = pack2(v[0], v[1]);
    ov[1] = pack2(v[2], v[3]);
    *(u32x2*)(WSP(u16, O_CKVN) + (size_t)16384 * 256 + i) = ov;
  }
}

enum { G_EVEN_IN = 0, G_ODD_IN, G_UPS, G_OUTP, G_FFNUP, G_FFNDN };
enum { EP_EVEN_IN = 0, EP_ODD_IN, EP_QUP, EP_KVUP, EP_RESID, EP_SWIGLU };

constexpr int G_LDS_STRIDE = 72;

DI void gemm_phase(const P& p, char* smem, int kind, int l) {
  u16* As = (u16*)smem;
  u16* Bs = As + 2 * 128 * G_LDS_STRIDE;
  const int eo = l >> 1;
  int ntiles_total, NT1 = 1, split = 0x7fffffff;
  switch (kind) {
    case G_EVEN_IN: NT1 = 26; ntiles_total = 128 * 26; break;
    case G_ODD_IN: NT1 = 14; ntiles_total = 128 * 14; break;
    case G_UPS: NT1 = 6; split = 128 * 6; ntiles_total = 128 * 6 + 160 * 8; break;
    case G_OUTP: NT1 = 8; ntiles_total = 128 * 8; break;
    case G_FFNUP: NT1 = 44; ntiles_total = 128 * 44; break;
    default: NT1 = 8; ntiles_total = 128 * 8; break;
  }
  const int bid = bid_opaque();
  const int xcd = bid & 7, slot = bid >> 3, nslots = gridDim.x >> 3;
  const int per_xcd1 = (kind == G_UPS) ? 16 * 6 : ntiles_total / 8;
  const int per_xcd = (kind == G_UPS) ? 16 * 6 + 20 * 8 : per_xcd1;
  (void)split;
  u32x4 ra0[4], rb0[4], ra1[4], rb1[4];
  if ((bid >> 8) & 1) { __builtin_amdgcn_s_sleep(12); }
  bool first_tile = true;
#define TILE_DESC(J, M0, N0, AP, BP, LDA, LDB, KK, EPI)                                                   \
  {                                                                                                       \
    const bool sec_ = (J) >= per_xcd1;                                                                    \
    const int jj_ = sec_ ? (J) - per_xcd1 : (J);                                                          \
    const int mper_ = sec_ ? 20 : 16;                                                                     \
    int mg_, rem_;     \
    switch (kind) {                                                                                       \
      case G_EVEN_IN: mg_ = jj_ / 208; rem_ = jj_ - mg_ * 208; break;                                     \
      case G_ODD_IN: mg_ = jj_ / 112; rem_ = jj_ - mg_ * 112; break;                                      \
      case G_UPS: if (!sec_) { mg_ = jj_ / 48; rem_ = jj_ - mg_ * 48; } else { mg_ = jj_ >> 6; rem_ = jj_ & 63; } break; \
      case G_FFNUP: mg_ = jj_ / 352; rem_ = jj_ - mg_ * 352; break;                                       \
      default: mg_ = jj_ >> 6; rem_ = jj_ & 63; break;                                                    \
    }                                                                                                     \
    const bool small_ = (mper_ - mg_ * 8) < 8;                   \
    const int nn_ = small_ ? rem_ >> 2 : rem_ >> 3, mi2_ = small_ ? rem_ & 3 : rem_ & 7;                  \
    M0 = (xcd * mper_ + mg_ * 8 + mi2_) * 128;                                                            \
    N0 = nn_ * 128;                                                                                       \
    switch (kind) {                                                                                       \
      case G_EVEN_IN:                                                                                     \
        AP = WSP(u16, O_HM); LDA = 1024; BP = WSP(u16, O_WAB) + (size_t)eo * 3328 * 1024; LDB = 1024; KK = 1024; EPI = EP_EVEN_IN; break; \
      case G_ODD_IN:                                                                                      \
        AP = WSP(u16, O_HM); LDA = 1024; BP = WSP(u16, O_WCD) + (size_t)eo * 1792 * 1024; LDB = 1024; KK = 1024; EPI = EP_ODD_IN; break; \
      case G_UPS:                                                                                         \
        if (!sec_) { AP = WSP(u16, O_PROJ); LDA = 1792; BP = WSP(u16, O_WQU) + (size_t)eo * 768 * 384; LDB = 384; KK = 384; EPI = EP_QUP; } \
        else { AP = WSP(u16, O_CKVN); LDA = 256; BP = WSP(u16, O_WKVU) + (size_t)eo * 1024 * 256; LDB = 256; KK = 256; EPI = EP_KVUP; } \
        break;                                                                                            \
      case G_OUTP:                                                                                        \
        AP = WSP(u16, O_HM); LDA = 1024; BP = WSP(u16, O_WO) + (size_t)l * 1024 * 1024; LDB = 1024; KK = 1024; EPI = EP_RESID; break; \
      case G_FFNUP:                                                                                       \
        AP = WSP(u16, O_HM); LDA = 1024; BP = WSP(u16, O_WGU) + (size_t)l * 5632 * 1024; LDB = 1024; KK = 1024; EPI = EP_SWIGLU; break; \
      default:                                                                                            \
        AP = WSP(u16, O_ACT); LDA = 2816; BP = WSP(u16, O_WD) + (size_t)l * 1024 * 2816; LDB = 2816; KK = 2816; EPI = EP_RESID; break; \
    }                                                                                                     \
  }
  for (int j = slot; j < per_xcd; j += nslots) {
    const int t = tid_opaque(), lane = t & 63, wave = t >> 6;
    const int wm = wave >> 1, wn = wave & 1, r = lane & 31, h = lane >> 5;
    const u16 *A, *Bt, *An, *Btn;
    int lda, ldb, K, m0, n0, epi, ldan, ldbn, Kn, m0n, n0n, epin;
    TILE_DESC(j, m0, n0, A, Bt, lda, ldb, K, epi)
    {
      const int jn = (j + nslots < per_xcd) ? j + nslots : j;
      TILE_DESC(jn, m0n, n0n, An, Btn, ldan, ldbn, Kn, epin)
      (void)Kn; (void)epin;
    }
    f32x16 acc[2][2];
#pragma unroll
    for (int a = 0; a < 2; ++a)
#pragma unroll
      for (int b = 0; b < 2; ++b) acc[a][b] = zero16();
    const int KT = K >> 6;
    const int lrow = t >> 3, lkc = (t & 7) * 8;
    const u16* Ag = A + (size_t)m0 * lda;
    const u16* Bg = Bt + (size_t)n0 * ldb;
    const u16* Agn = An + (size_t)m0n * ldan;
    const u16* Bgn = Btn + (size_t)n0n * ldbn;
    const unsigned loA = (unsigned)(lrow * lda + lkc) * 2u, loB = (unsigned)(lrow * ldb + lkc) * 2u;
    const unsigned loAn = (unsigned)(lrow * ldan + lkc) * 2u, loBn = (unsigned)(lrow * ldbn + lkc) * 2u;
#define G_LOAD(RA, RB, V)                                                           \
  {                                                                                 \
    const int v_ = (V);                                                             \
    const bool nx_ = v_ >= KT;                                                      \
    const int kk_ = (nx_ ? v_ - KT : v_) * 128;                                     \
    const auto ra_ = __builtin_amdgcn_make_buffer_rsrc((void*)(nx_ ? Agn : Ag), (short)0, 0x40000000, 0x00020000); \
    const auto rb_ = __builtin_amdgcn_make_buffer_rsrc((void*)(nx_ ? Bgn : Bg), (short)0, 0x40000000, 0x00020000); \
    const int la_ = (nx_ ? ldan : lda) * 64, lb_ = (nx_ ? ldbn : ldb) * 64;         \
    const unsigned oa_ = nx_ ? loAn : loA, ob_ = nx_ ? loBn : loB;                  \
    _Pragma("unroll") for (int i = 0; i < 4; ++i) {                                 \
      RA[i] = __builtin_amdgcn_raw_buffer_load_b128(ra_, oa_, kk_ + i * la_, 0);    \
      RB[i] = __builtin_amdgcn_raw_buffer_load_b128(rb_, ob_, kk_ + i * lb_, 0);    \
    }                                                                               \
  }
#define G_STORE(RA, RB, BUF)                                                        \
  _Pragma("unroll") for (int i = 0; i < 4; ++i) {                                   \
    *(u32x4*)(As + (BUF) * 128 * G_LDS_STRIDE + (lrow + 32 * i) * G_LDS_STRIDE + lkc) = RA[i]; \
    *(u32x4*)(Bs + (BUF) * 128 * G_LDS_STRIDE + (lrow + 32 * i) * G_LDS_STRIDE + lkc) = RB[i]; \
  }
#define G_FRAGS(BUF)                                                                \
  {                                                                                 \
    const u16* Ab = As + (BUF) * 128 * G_LDS_STRIDE + (wm * 64 + r) * G_LDS_STRIDE + h * 8; \
    const u16* Bb = Bs + (BUF) * 128 * G_LDS_STRIDE + (wn * 64 + r) * G_LDS_STRIDE + h * 8; \
    _Pragma("unroll") for (int ks = 0; ks < 4; ++ks) {                              \
      fa[ks][0] = *(const bf16x8*)(Ab + ks * 16);                                   \
      fb[ks][0] = *(const bf16x8*)(Bb + ks * 16);                                   \
      fa[ks][1] = *(const bf16x8*)(Ab + 32 * G_LDS_STRIDE + ks * 16);               \
      fb[ks][1] = *(const bf16x8*)(Bb + 32 * G_LDS_STRIDE + ks * 16);               \
    }                                                                               \
  }
#define G_MFMAS()                                                                   \
  _Pragma("unroll") for (int ks = 0; ks < 4; ++ks) {                                \
    acc[0][0] = MFMA(fa[ks][0], fb[ks][0], acc[0][0]);                              \
    acc[0][1] = MFMA(fa[ks][0], fb[ks][1], acc[0][1]);                              \
    acc[1][0] = MFMA(fa[ks][1], fb[ks][0], acc[1][0]);                              \
    acc[1][1] = MFMA(fa[ks][1], fb[ks][1], acc[1][1]);                              \
  }
#define G_INTERLEAVE()                                                              \
  _Pragma("unroll") for (int q = 0; q < 8; ++q) {                                   \
    __builtin_amdgcn_sched_group_barrier(0x008, 1, 0);                              \
    __builtin_amdgcn_sched_group_barrier(0x200, 1, 0);                              \
  }                                                                                 \
  _Pragma("unroll") for (int q = 0; q < 8; ++q) {                                   \
    __builtin_amdgcn_sched_group_barrier(0x008, 1, 0);                              \
    __builtin_amdgcn_sched_group_barrier(0x020, 1, 0);                              \
  }
    bf16x8 fa[4][2], fb[4][2];
    if (first_tile) {
      first_tile = false;
      G_LOAD(ra0, rb0, 0)
      G_LOAD(ra1, rb1, 1)
      G_STORE(ra0, rb0, 0)
      G_LOAD(ra0, rb0, 2)
      __builtin_amdgcn_sched_barrier(0);
      __syncthreads();
    }
    for (int kt = 0; kt < KT; kt += 2) {
      G_FRAGS(0)
      __builtin_amdgcn_sched_barrier(0);
      G_STORE(ra1, rb1, 1)
      G_LOAD(ra1, rb1, kt + 3)
      G_MFMAS()
      G_INTERLEAVE()
      __builtin_amdgcn_sched_barrier(0);
      __syncthreads();
      G_FRAGS(1)
      __builtin_amdgcn_sched_barrier(0);
      G_STORE(ra0, rb0, 0)
      G_LOAD(ra0, rb0, kt + 4)
      G_MFMAS()
      G_INTERLEAVE()
      __builtin_amdgcn_sched_barrier(0);
      __syncthreads();
    }
#undef G_FRAGS
#undef G_MFMAS
#undef G_INTERLEAVE
#undef G_LOAD
#undef G_STORE
    const int rowb = m0 + wm * 64;
    const int colb = n0 + wn * 64;
    const bool lat = m0 >= NPR && m0 < NROWS;
    const int mi_mod = mod_index(m0 < NROWS ? m0 : 0);
    if (epi == EP_RESID) {
      const int gsel = (kind == G_OUTP) ? 2 : 5;
      const bool from_input = (kind == G_OUTP) && (l == 0);
      const int pln = (kind == G_OUTP) ? (l - 1) * 2 + 1 : l * 2;
      const float* md = WSP(float, O_MOD) + (size_t)(l * 9 + mi_mod) * 6144 + gsel * 1024;
      const char* xb0 = (const char*)(from_input ? x_input_row(p, m0) : p.out + (size_t)m0 * 1024);
      char* ob0 = (char*)(p.out + (size_t)m0 * 1024);
      const char* st0 = (const char*)WSP(float, O_ST);
      const int col0 = colb + r, col1 = col0 + 32;
      const unsigned lo0 = ((unsigned)(wm * 64 + 4 * h) * 1024u + (unsigned)col0) * 4u;
      const unsigned ls0 = (unsigned)(rowb + 4 * h) * 8u;
      const float gate0 = md[col0], gate1 = md[col1];
      float g0 = 1.f, g1 = 1.f, b0 = 0.f, b1 = 0.f;
      if (!from_input) {
        g0 = p.ln_g[pln * 1024 + col0]; g1 = p.ln_g[pln * 1024 + col1];
        b0 = p.ln_b[pln * 1024 + col0]; b1 = p.ln_b[pln * 1024 + col1];
      }
#pragma unroll
      for (int mi = 0; mi < 2; ++mi)
#pragma unroll
        for (int i = 0; i < 16; ++i) {
          const int ro = mi * 32 + crow(i, 0);
          float mean = 0.f, rstd = 1.f;
          if (!from_input) {
            const f32v2 st = *(const f32v2*)(st0 + ls0 + (unsigned)(ro * 8));
            mean = st[0];
            rstd = st[1];
          }
          const unsigned o0 = lo0 + (unsigned)(ro * 4096);
          const float x0 = (*(const float*)(xb0 + o0) - mean) * rstd * g0 + b0;
          const float x1 = (*(const float*)(xb0 + o0 + 128u) - mean) * rstd * g1 + b1;
          *(float*)(ob0 + o0) = ALPHA_F * x0 + gate0 * acc[mi][0][i];
          *(float*)(ob0 + o0 + 128u) = ALPHA_F * x1 + gate1 * acc[mi][1][i];
        }
    } else if (epi == EP_SWIGLU) {
      const int j = ((n0 >> 6) + wn) * 32 + r;
      u16* act = WSP(u16, O_ACT);
      const unsigned lofs = ((unsigned)(rowb + 4 * h) * 2816u + (unsigned)j) * 2u;
#pragma unroll
      for (int mi = 0; mi < 2; ++mi)
#pragma unroll
        for (int i = 0; i < 16; ++i)
          st_u16(act, lofs + (unsigned)((mi * 32 + crow(i, 0)) * 2816 * 2), f2bf(silu_f(acc[mi][0][i]) * acc[mi][1][i]));
    } else if (epi == EP_EVEN_IN) {
      const float* cs64 = WSP(float, O_CS64);
#pragma unroll
      for (int ni = 0; ni < 2; ++ni) {
        const int cbase = colb + ni * 32;
        const int col = cbase + r;
        if (cbase < 640) {
          u16* dst0 = cbase < 512 ? WSP(u16, O_QA) : WSP(u16, O_KA);
          const int ldd = cbase < 512 ? 512 : 128;
          const unsigned lofs = ((unsigned)(rowb + 4 * h) * (unsigned)ldd + (unsigned)(cbase < 512 ? col : col - 512)) * 2u;
          const bool rowblk = (cbase & 32) == 0;
          const bool first = (r & 16) == 0;
#pragma unroll
          for (int mi = 0; mi < 2; ++mi)
#pragma unroll
            for (int i = 0; i < 16; ++i) {
              if ((i & 3) == 0) SB();
              const int R = rowb + mi * 32 + crow(i, h);
              float v = acc[mi][ni][i];
              const float pv = __shfl_xor(v, 16);
              if (lat) {
                const int tk = (R - NPR) & 1023;
                const int pos = rowblk ? (tk >> 6) : (tk & 63);
                const float cc = cs64[(pos * 16 + (r & 15)) * 2], sn = cs64[(pos * 16 + (r & 15)) * 2 + 1];
                v = first ? v * cc - pv * sn : v * cc + pv * sn;
              } else if (cbase >= 512) {
                p.out[OUT_AK + (((size_t)(R >> 8) * 2 + eo) * 256 + (R & 255)) * 128 + (col - 512)] = v;
              }
              st_u16(dst0, lofs + (unsigned)((mi * 32 + crow(i, 0)) * 2) * (unsigned)ldd, f2bf(v));
            }
        } else if (cbase < 768) {
          const int c = col - 640, kvh = c >> 6, d = c & 63;
#pragma unroll
          for (int mi = 0; mi < 2; ++mi)
#pragma unroll
            for (int g4 = 0; g4 < 4; ++g4) {
              SB();
              const int R0 = rowb + mi * 32 + 8 * g4 + 4 * h;
              u32x2 ov;
              ov[0] = pack2(acc[mi][ni][4 * g4], acc[mi][ni][4 * g4 + 1]);
              ov[1] = pack2(acc[mi][ni][4 * g4 + 2], acc[mi][ni][4 * g4 + 3]);
              if (lat) {
                const int b = (R0 - NPR) >> 10, tk = (R0 - NPR) & 1023;
                *(u32x2*)(WSP(u16, O_VTAL) + ((size_t)((eo * 8 + b) * 2 + kvh) * 64 + d) * 1536 + tk) = ov;
              } else {
                const int b = R0 >> 8, tk = R0 & 255;
                *(u32x2*)(WSP(u16, O_VTAP) + ((size_t)(b * 2 + kvh) * 64 + d) * 256 + tk) = ov;
#pragma unroll
                for (int k = 0; k < 4; ++k)
                  p.out[OUT_AV + (((size_t)b * 2 + eo) * 256 + tk + k) * 128 + c] = acc[mi][ni][4 * g4 + k];
              }
            }
        } else if (cbase < 1792 || cbase >= 2816) {
          u16* dst;
          bool do_silu = true;
          int cofs;
          if (cbase < 1280) { dst = WSP(u16, O_QB); cofs = col - 768; }
          else if (cbase < 1792) { dst = WSP(u16, O_IB); cofs = col - 1280; do_silu = false; }
          else { dst = WSP(u16, O_GB); cofs = col - 2816; }
          const unsigned lofs = ((unsigned)(rowb + 4 * h) * 512u + (unsigned)cofs) * 2u;
#pragma unroll
          for (int mi = 0; mi < 2; ++mi)
#pragma unroll
            for (int i = 0; i < 16; ++i) {
              if ((i & 3) == 0) SB();
              const int R = rowb + mi * 32 + crow(i, h);
              const float v = acc[mi][ni][i];
              st_u16(dst, lofs + (unsigned)((mi * 32 + crow(i, 0)) * 512 * 2), f2bf(do_silu ? silu_f(v) : v));
            }
        } else {
          const bool fwd = cbase < 2304;
          const int cc = col - (fwd ? 1792 : 2304);
          const float lb = WSP(float, O_LBT)[(eo * 2 + (fwd ? 0 : 1)) * 512 + cc];
          float* dst = WSP(float, fwd ? O_FF : O_FB);
          const unsigned lofs = ((unsigned)(rowb + 4 * h) * 512u + (unsigned)cc) * 4u;
#pragma unroll
          for (int mi = 0; mi < 2; ++mi)
#pragma unroll
            for (int i = 0; i < 16; ++i) {
              if ((i & 3) == 0) SB();
              const int R = rowb + mi * 32 + crow(i, h);
              st_f32(dst, lofs + (unsigned)((mi * 32 + crow(i, 0)) * 512 * 4), lb + (1.f - lb) * sigmoid_f(acc[mi][ni][i]));
            }
        }
      }
    } else if (epi == EP_ODD_IN) {
#pragma unroll
      for (int ni = 0; ni < 2; ++ni) {
        const int cbase = colb + ni * 32;
        const int col = cbase + r;
        if (cbase >= 1408 && cbase < 1664) {
          const int c = col - 1408, kvh = c >> 6, d = c & 63;
#pragma unroll
          for (int mi = 0; mi < 2; ++mi)
#pragma unroll
            for (int g4 = 0; g4 < 4; ++g4) {
              SB();
              const int R0 = rowb + mi * 32 + 8 * g4 + 4 * h;
              u32x2 ov;
              ov[0] = pack2(acc[mi][ni][4 * g4], acc[mi][ni][4 * g4 + 1]);
              ov[1] = pack2(acc[mi][ni][4 * g4 + 2], acc[mi][ni][4 * g4 + 3]);
              if (lat) {
                const int b = (R0 - NPR) >> 10, tk = (R0 - NPR) & 1023;
                *(u32x2*)(WSP(u16, O_VTDL) + ((size_t)((eo * 8 + b) * 4 + kvh) * 64 + d) * 1536 + tk) = ov;
              } else {
                const int b = R0 >> 8, tk = R0 & 255;
                *(u32x2*)(WSP(u16, O_VTDP) + ((size_t)(b * 4 + kvh) * 64 + d) * 256 + tk) = ov;
#pragma unroll
                for (int k = 0; k < 4; ++k)
                  p.out[OUT_DV + (((size_t)b * 2 + eo) * 256 + tk + k) * 256 + c] = acc[mi][ni][4 * g4 + k];
              }
            }
        } else if (cbase < 1696) {
          u16* dst = WSP(u16, O_PROJ);
          const unsigned lofs = ((unsigned)(rowb + 4 * h) * 1792u + (unsigned)col) * 2u;
#pragma unroll
          for (int mi = 0; mi < 2; ++mi)
#pragma unroll
            for (int i = 0; i < 16; ++i) {
              if ((i & 3) == 0) SB();
              const int R = rowb + mi * 32 + crow(i, h);
              st_u16(dst, lofs + (unsigned)((mi * 32 + crow(i, 0)) * 1792 * 2), f2bf(acc[mi][ni][i]));
            }
        }
      }
    } else if (epi == EP_QUP) {
      const float* cs32 = WSP(float, O_CS32);
      const float* rcq = WSP(float, O_RCQ);
#pragma unroll
      for (int ni = 0; ni < 2; ++ni) {
        const int cbase = colb + ni * 32;
        const int col = cbase + r;
        const bool ropeblk = ((cbase >> 5) % 3) == 2;
        const bool first = (r & 8) == 0;
        u16* dst = WSP(u16, O_QC);
        const unsigned lofs = ((unsigned)(rowb + 4 * h) * 768u + (unsigned)col) * 2u;
#pragma unroll
        for (int mi = 0; mi < 2; ++mi)
#pragma unroll
          for (int i = 0; i < 16; ++i) {
            if ((i & 3) == 0) SB();
            const int R = rowb + mi * 32 + crow(i, h);
            float v = acc[mi][ni][i] * rcq[R];
            const float pv = __shfl_xor(v, 8);
            if (lat && ropeblk) {
              const int tk = (R - NPR) & 1023;
              const int pos = (r < 16) ? (tk >> 6) : (tk & 63);
              const float cc = cs32[(pos * 8 + (r & 7)) * 2], sn = cs32[(pos * 8 + (r & 7)) * 2 + 1];
              v = first ? v * cc - pv * sn : v * cc + pv * sn;
            }
            st_u16(dst, lofs + (unsigned)((mi * 32 + crow(i, 0)) * 768 * 2), f2bf(v));
          }
      }
    } else {
#pragma unroll
      for (int ni = 0; ni < 2; ++ni) {
        const int cbase = colb + ni * 32;
        const int col = cbase + r;
        const int head = col >> 7, hc = col & 127;
        if ((cbase & 64) == 0) {
          u16* dst = WSP(u16, O_KN);
          const unsigned lofs = ((unsigned)(rowb + 4 * h) * 512u + (unsigned)(head * 64 + hc)) * 2u;
#pragma unroll
          for (int mi = 0; mi < 2; ++mi)
#pragma unroll
            for (int i = 0; i < 16; ++i) {
              if ((i & 3) == 0) SB();
              const int R = rowb + mi * 32 + crow(i, h);
              st_u16(dst, lofs + (unsigned)((mi * 32 + crow(i, 0)) * 512 * 2), f2bf(acc[mi][ni][i]));
            }
        } else {
          const int d = hc - 64;
#pragma unroll
          for (int mi = 0; mi < 2; ++mi)
#pragma unroll
            for (int g4 = 0; g4 < 4; ++g4) {
              SB();
              const int R0 = rowb + mi * 32 + 8 * g4 + 4 * h;
              u32x2 ov;
              ov[0] = pack2(acc[mi][ni][4 * g4], acc[mi][ni][4 * g4 + 1]);
              ov[1] = pack2(acc[mi][ni][4 * g4 + 2], acc[mi][ni][4 * g4 + 3]);
              u16* dp;
              if (R0 < NPR) dp = WSP(u16, O_VTCP) + ((size_t)((R0 >> 8) * 8 + head) * 64 + d) * 256 + (R0 & 255);
              else if (R0 < NROWS)
                dp = WSP(u16, O_VTCL) + ((size_t)(((R0 - NPR) >> 10) * 8 + head) * 64 + d) * 1536 + ((R0 - NPR) & 1023);
              else
                dp = WSP(u16, O_VTCL) + ((size_t)(((R0 - NROWS) >> 9) * 8 + head) * 64 + d) * 1536 + 1024 + ((R0 - NROWS) & 511);
              *(u32x2*)dp = ov;
            }
        }
      }
    }
  }
}

struct AttnArgs {
  const u16* Q; int ldq;
  const u16* K0; int ldk0; const u16* PE0; int kb0, ke0;
  const u16* K1; int ldk1; const u16* PE1; int ke1;
  const u16* VT; int ldvt; int vtoff1;
  int banded; int qpos0;
  int has_sink; float sink;
  float scale;
  u16* O;
};

template <int DQK>
DI void attn_item(char* smem, const AttnArgs& a) {
  constexpr int KSTR = DQK + 8;
  constexpr int VSTR = 72;
  constexpr int NKS = DQK / 16;
  constexpr int ASTAGE = 64 * KSTR + 64 * VSTR;
  u16* Ks0 = (u16*)smem;
  const int t = tid_opaque(), lane = t & 63, w = t >> 6, r = lane & 31, h = lane >> 5;
  bf16x8 qf[NKS];
  {
    const u16* qp = a.Q + (size_t)(32 * w + r) * a.ldq + 8 * h;
#pragma unroll
    for (int ks = 0; ks < NKS; ++ks) qf[ks] = *(const bf16x8*)(qp + 16 * ks);
  }
  const float sl2 = a.scale * LOG2E;
  float m = a.has_sink ? a.sink * LOG2E : -1e30f;
  float lsum = a.has_sink ? 1.f : 0.f;
  f32x16 O0 = zero16(), O1 = zero16();
  const int qp_me = a.qpos0 + 32 * w + r;
  const int n0 = (a.ke0 - a.kb0) >> 6, nt = n0 + (a.ke1 >> 6);
  u32x4 kreg[2], vreg[2], preg;
#define A_ISSUE(TI)                                                                          \
  {                                                                                          \
    const int ti_ = (TI);                                                                    \
    const bool s1_ = ti_ >= n0;                                                              \
    const u16* Kp_ = s1_ ? a.K1 : a.K0;                                                      \
    const int ldk_ = s1_ ? a.ldk1 : a.ldk0;                                                  \
    const int k0_ = s1_ ? (ti_ - n0) * 64 : a.kb0 + ti_ * 64;                                \
    const int vo_ = (s1_ ? a.vtoff1 : 0) + k0_;                                              \
    _Pragma("unroll") for (int i = 0; i < 2; ++i) {                                          \
      const int c = t + 256 * i, key = c >> 3, dc = c & 7;                                   \
      kreg[i] = *(const u32x4*)(Kp_ + (size_t)(k0_ + key) * ldk_ + dc * 8);                  \
      vreg[i] = *(const u32x4*)(a.VT + (size_t)key * a.ldvt + vo_ + dc * 8);                 \
    }                                                                                        \
    if (DQK == 96) {                                                                         \
      const u16* PEp_ = s1_ ? a.PE1 : a.PE0;                                                 \
      preg = *(const u32x4*)(PEp_ + (size_t)(k0_ + (t >> 2)) * 32 + (t & 3) * 8);            \
    }                                                                                        \
  }
  A_ISSUE(0)
  for (int ti = 0; ti < nt; ++ti) {
    {
      const bool seg1 = ti >= n0;
      const int key0 = seg1 ? (ti - n0) * 64 : a.kb0 + ti * 64;
      const bool band = a.banded && !seg1;
      u16* Ks = Ks0 + (ti & 1) * ASTAGE;
      u16* Vs = Ks + 64 * KSTR;
#pragma unroll
      for (int i = 0; i < 2; ++i) {
        const int c = t + 256 * i, key = c >> 3, dc = c & 7;
        *(u32x4*)(Ks + key * KSTR + dc * 8) = kreg[i];
        *(u32x4*)(Vs + key * VSTR + dc * 8) = vreg[i];
      }
      if (DQK == 96) *(u32x4*)(Ks + (t >> 2) * KSTR + 64 + (t & 3) * 8) = preg;
      __syncthreads();
      A_ISSUE(ti + 1 < nt ? ti + 1 : ti)
      __builtin_amdgcn_sched_barrier(0);
      f32x16 S0 = zero16(), S1 = zero16();
      __builtin_amdgcn_s_setprio(1);
#pragma unroll
      for (int ks = 0; ks < NKS; ++ks) {
        const bf16x8 k0 = *(const bf16x8*)(Ks + r * KSTR + 16 * ks + 8 * h);
        const bf16x8 k1 = *(const bf16x8*)(Ks + (32 + r) * KSTR + 16 * ks + 8 * h);
        S0 = MFMA(k0, qf[ks], S0);
        S1 = MFMA(k1, qf[ks], S1);
      }
      __builtin_amdgcn_s_setprio(0);
      float tmax = -INFINITY;
#pragma unroll
      for (int i = 0; i < 16; ++i) {
        float x0 = S0[i] * sl2, x1 = S1[i] * sl2;
        if (band) {
          const int kp0 = key0 + crow(i, h), kp1 = kp0 + 32;
          int d0 = qp_me - kp0, d1 = qp_me - kp1;
          d0 = d0 < 0 ? -d0 : d0;
          d1 = d1 < 0 ? -d1 : d1;
          if (d0 > 128) x0 = -INFINITY;
          if (d1 > 128) x1 = -INFINITY;
        }
        S0[i] = x0;
        S1[i] = x1;
        tmax = fmaxf(tmax, fmaxf(x0, x1));
      }
      tmax = xhalf_max(tmax);
      const float mnew = (tmax > m + 8.f) ? tmax : m;
      const float alpha = __builtin_amdgcn_exp2f(m - mnew);
      float rs = 0.f;
#pragma unroll
      for (int i = 0; i < 16; ++i) {
        S0[i] = __builtin_amdgcn_exp2f(S0[i] - mnew);
        S1[i] = __builtin_amdgcn_exp2f(S1[i] - mnew);
        rs += S0[i] + S1[i];
      }
      rs = xhalf_sum(rs);
      lsum = lsum * alpha + rs;
      m = mnew;
#pragma unroll
      for (int i = 0; i < 16; ++i) {
        O0[i] *= alpha;
        O1[i] *= alpha;
      }
      __builtin_amdgcn_s_setprio(1);
      const u16* v0p = Vs + r * VSTR + 4 * h;
      const u16* v1p = Vs + (32 + r) * VSTR + 4 * h;
      {
        const bf16x8 pb = pack8<0>(S0);
        O0 = MFMA(cat4(*(const s16x4*)(v0p + 0), *(const s16x4*)(v0p + 8)), pb, O0);
        O1 = MFMA(cat4(*(const s16x4*)(v1p + 0), *(const s16x4*)(v1p + 8)), pb, O1);
      }
      {
        const bf16x8 pb = pack8<1>(S0);
        O0 = MFMA(cat4(*(const s16x4*)(v0p + 16), *(const s16x4*)(v0p + 24)), pb, O0);
        O1 = MFMA(cat4(*(const s16x4*)(v1p + 16), *(const s16x4*)(v1p + 24)), pb, O1);
      }
      {
        const bf16x8 pb = pack8<0>(S1);
        O0 = MFMA(cat4(*(const s16x4*)(v0p + 32), *(const s16x4*)(v0p + 40)), pb, O0);
        O1 = MFMA(cat4(*(const s16x4*)(v1p + 32), *(const s16x4*)(v1p + 40)), pb, O1);
      }
      {
        const bf16x8 pb = pack8<1>(S1);
        O0 = MFMA(cat4(*(const s16x4*)(v0p + 48), *(const s16x4*)(v0p + 56)), pb, O0);
        O1 = MFMA(cat4(*(const s16x4*)(v1p + 48), *(const s16x4*)(v1p + 56)), pb, O1);
      }
      __builtin_amdgcn_s_setprio(0);
    }
  }
  __syncthreads();
#undef A_ISSUE
  const float inv = 1.f / lsum;
  u16* op = a.O + (size_t)(32 * w + r) * 1024 + 4 * h;
#pragma unroll
  for (int g4 = 0; g4 < 4; ++g4) {
    u32x2 o0, o1;
    o0[0] = pack2(O0[4 * g4] * inv, O0[4 * g4 + 1] * inv);
    o0[1] = pack2(O0[4 * g4 + 2] * inv, O0[4 * g4 + 3] * inv);
    o1[0] = pack2(O1[4 * g4] * inv, O1[4 * g4 + 1] * inv);
    o1[1] = pack2(O1[4 * g4 + 2] * inv, O1[4 * g4 + 3] * inv);
    *(u32x2*)(op + 8 * g4) = o0;
    *(u32x2*)(op + 32 + 8 * g4) = o1;
  }
}

DI void hgrn_item(char* smem, const P& p, int e, int item) {
  u16* Qs = (u16*)smem;
  u16* Ks = Qs + 32 * 136;
  u16* KhT = Ks + 32 * 136;
  u16* VTs = KhT + 128 * 40;
  float* dec = (float*)(VTs + 128 * 40);
  float* Tx = dec + 128;
  const int t = tid_opaque(), lane = t & 63, w = t >> 6, r = lane & 31, hh = lane >> 5;
  const bool lat = item < 64;
  int b, hd, dir;
  if (lat) { b = item >> 3; hd = (item >> 1) & 3; dir = item & 1; }
  else { const int q = item - 64; b = q >> 3; hd = (q >> 1) & 3; dir = q & 1; }
  const int L = lat ? 1024 : 256;
  const int rowbase = lat ? NPR + b * 1024 : b * 256;
  const int nchunks = L >> 5;
  const float* Fsrc = WSP(float, dir ? O_FB : O_FF) + hd * 128;
  const u16* Qsrc = WSP(u16, O_QB) + hd * 128;
  const u16* Vsrc = WSP(u16, O_IB) + hd * 128;
  float* Odst = WSP(float, O_OFB) + (size_t)dir * NROWS * 512 + hd * 128;
  f32x16 St[4];
  if (lat) {
    const float* s0 = p.state_b + ((((size_t)b * 2 + e) * 2 + dir) * 4 + hd) * 16384;
#pragma unroll
    for (int kb = 0; kb < 4; ++kb)
#pragma unroll
      for (int i = 0; i < 16; ++i) St[kb][i] = s0[(size_t)(32 * kb + crow(i, hh)) * 128 + 32 * w + r];
  } else {
#pragma unroll
    for (int kb = 0; kb < 4; ++kb) St[kb] = zero16();
  }
  const int kk = 32 * w + r, half = hh;
  float fr[16];
  unsigned qp[8], vp[8];
#pragma unroll
  for (int i = 0; i < 8; ++i) {
    const int tt = 16 * half + 2 * i;
    const int row0 = rowbase + (dir ? L - 1 - tt : tt);
    const int row1 = dir ? row0 - 1 : row0 + 1;
    fr[2 * i] = Fsrc[(size_t)row0 * 512 + kk];
    fr[2 * i + 1] = Fsrc[(size_t)row1 * 512 + kk];
    qp[i] = (unsigned)Qsrc[(size_t)row0 * 512 + kk] | ((unsigned)Qsrc[(size_t)row1 * 512 + kk] << 16);
    vp[i] = (unsigned)Vsrc[(size_t)row0 * 512 + kk] | ((unsigned)Vsrc[(size_t)row1 * 512 + kk] << 16);
  }
  for (int n = 0; n < nchunks; ++n) {
    float cl[16];
    {
      float c = 0.f;
#pragma unroll
      for (int i = 0; i < 16; ++i) {
        c += __logf(fmaxf(fr[i], 1e-30f));
        cl[i] = c;
      }
      cl[15] = c;
    }
    {
      float T0, T1;
      {
        auto rr2 = __builtin_amdgcn_permlane32_swap(__float_as_uint(cl[15]), __float_as_uint(cl[15]), false, false);
        T0 = __uint_as_float(rr2[0]);
        T1 = __uint_as_float(rr2[1]);
      }
      const float last = T0 + T1, off = half ? T0 : 0.f;
      float khv[16];
#pragma unroll
      for (int i = 0; i < 16; ++i) {
        const float cum = cl[i] + off;
        const int s = 16 * half + i;
        const float kvv = 1.f - fr[i];
        const float qv = __uint_as_float((i & 1) ? (qp[i >> 1] & 0xffff0000u) : (qp[i >> 1] << 16));
        Qs[s * 136 + kk] = f2bf(qv * 0.08838834764831845f * __expf(cum));
        Ks[s * 136 + kk] = f2bf(kvv * __expf(fminf(-cum, 80.f)));
        khv[i] = kvv * __expf(last - cum);
      }
      u32x4 k0, k1, v0, v1;
#pragma unroll
      for (int q = 0; q < 4; ++q) {
        k0[q] = pack2(khv[2 * q], khv[2 * q + 1]);
        k1[q] = pack2(khv[8 + 2 * q], khv[8 + 2 * q + 1]);
        v0[q] = vp[q];
        v1[q] = vp[4 + q];
      }
      *(u32x4*)(KhT + kk * 40 + 16 * half) = k0;
      *(u32x4*)(KhT + kk * 40 + 16 * half + 8) = k1;
      *(u32x4*)(VTs + kk * 40 + 16 * half) = v0;
      *(u32x4*)(VTs + kk * 40 + 16 * half + 8) = v1;
      if (half == 0) dec[kk] = __expf(last);
    }
    if (n + 1 < nchunks) {
#pragma unroll
      for (int i = 0; i < 8; ++i) {
        const int tt = (n + 1) * 32 + 16 * half + 2 * i;
        const int row0 = rowbase + (dir ? L - 1 - tt : tt);
        const int row1 = dir ? row0 - 1 : row0 + 1;
        fr[2 * i] = Fsrc[(size_t)row0 * 512 + kk];
        fr[2 * i + 1] = Fsrc[(size_t)row1 * 512 + kk];
        qp[i] = (unsigned)Qsrc[(size_t)row0 * 512 + kk] | ((unsigned)Qsrc[(size_t)row1 * 512 + kk] << 16);
        vp[i] = (unsigned)Vsrc[(size_t)row0 * 512 + kk] | ((unsigned)Vsrc[(size_t)row1 * 512 + kk] << 16);
      }
    }
    __syncthreads();
    __builtin_amdgcn_s_setprio(1);
    f32x16 oacc = zero16();
#pragma unroll
    for (int kb = 0; kb < 4; ++kb) {
      const u16* qp = Qs + r * 136 + 32 * kb + 4 * hh;
      oacc = MFMA(pack8<0>(St[kb]), cat4(*(const s16x4*)(qp), *(const s16x4*)(qp + 8)), oacc);
      oacc = MFMA(pack8<1>(St[kb]), cat4(*(const s16x4*)(qp + 16), *(const s16x4*)(qp + 24)), oacc);
    }
    {
      f32x16 at = zero16();
#pragma unroll
      for (int ks = 0; ks < 8; ++ks) {
        const bf16x8 ka = *(const bf16x8*)(Ks + r * 136 + 16 * ks + 8 * hh);
        const bf16x8 qb = *(const bf16x8*)(Qs + r * 136 + 16 * ks + 8 * hh);
        at = MFMA(ka, qb, at);
      }
#pragma unroll
      for (int i = 0; i < 16; ++i)
        if (crow(i, hh) > r) at[i] = 0.f;
      const u16* vp = VTs + (32 * w + r) * 40 + 4 * hh;
      oacc = MFMA(cat4(*(const s16x4*)(vp), *(const s16x4*)(vp + 8)), pack8<0>(at), oacc);
      oacc = MFMA(cat4(*(const s16x4*)(vp + 16), *(const s16x4*)(vp + 24)), pack8<1>(at), oacc);
    }
#pragma unroll
    for (int kb = 0; kb < 4; ++kb) {
#pragma unroll
      for (int g4 = 0; g4 < 4; ++g4) {
        const f32x4 dv = *(const f32x4*)(dec + 32 * kb + 8 * g4 + 4 * hh);
#pragma unroll
        for (int k = 0; k < 4; ++k) St[kb][4 * g4 + k] *= dv[k];
      }
#pragma unroll
      for (int ks = 0; ks < 2; ++ks) {
        const bf16x8 ka = *(const bf16x8*)(KhT + (32 * kb + r) * 40 + 16 * ks + 8 * hh);
        const bf16x8 vb = *(const bf16x8*)(VTs + (32 * w + r) * 40 + 16 * ks + 8 * hh);
        St[kb] = MFMA(ka, vb, St[kb]);
      }
    }
    __builtin_amdgcn_s_setprio(0);
    {
      const int tt = n * 32 + r;
      const int row = rowbase + (dir ? L - 1 - tt : tt);
      float* od = Odst + (size_t)row * 512 + 32 * w + 4 * hh;
#pragma unroll
      for (int g4 = 0; g4 < 4; ++g4) {
        f32x4 v;
#pragma unroll
        for (int k = 0; k < 4; ++k) v[k] = oacc[4 * g4 + k];
        *(f32x4*)(od + 8 * g4) = v;
      }
    }
    __syncthreads();
  }
  if (!lat) {
    float* sd = p.out + OUT_SB + ((((size_t)b * 2 + e) * 2 + dir) * 4 + hd) * 16384;
#pragma unroll
    for (int kb = 0; kb < 4; ++kb)
#pragma unroll
      for (int i = 0; i < 16; ++i) sd[(size_t)(32 * kb + crow(i, hh)) * 128 + 32 * w + r] = St[kb][i];
  }
}

DI int queue_next(char* smem, unsigned* ctr) {
  int* slot = (int*)(smem + 73728 - 16);
  if (tid_opaque() == 0) *slot = (int)atomicAdd(ctr, 1u);
  __syncthreads();
  const int item = *slot;
  __syncthreads();
  return item;
}

DI void mixer_even_phase(const P& p, char* smem, int e) {
  const int xg = bid_opaque() & 7;
  unsigned* ctr = (unsigned*)(p.ws + O_BAR) + 3600 + 64 * e + xg;
  for (;;) {
    const int qi = queue_next(smem, ctr);
    if (qi >= 168) {
      const int ndef = (e == 0 ? NDEF0 : NDEF1);
      int dq = xg + 8 * (qi - 168);
      if (dq >= ndef) break;
      float* smf = (float*)smem;
      int ta = deferred_task(e, dq), tb = 0;
      float va[32], vb[32];
      transpose_load(tdesc(p, ta), va);
      for (;;) {
        dq = xg + 8 * (queue_next(smem, ctr) - 168);
        const bool hb = dq < ndef;
        tb = deferred_task(e, hb ? dq : 0);
        transpose_load(tdesc(p, tb), vb);
        transpose_finish(smf, tdesc(p, ta), va);
        if (!hb) break;
        dq = xg + 8 * (queue_next(smem, ctr) - 168);
        const bool ha = dq < ndef;
        ta = deferred_task(e, ha ? dq : 0);
        transpose_load(tdesc(p, ta), va);
        transpose_finish(smf, tdesc(p, tb), vb);
        if (!ha) break;
      }
      break;
    }
    int item;
    if (qi < 8) item = xg * 8 + qi;
    else if (qi < 72) item = 320 + xg * 64 + (qi - 8);
    else if (qi < 104) item = 64 + xg * 32 + (qi - 72);
    else item = 320 + 512 + xg * 64 + (qi - 104);
    if (item < 320) {
      hgrn_item(smem, p, e, item);
    } else {
      AttnArgs a;
      const int q = item - 320;
      a.ldq = 512; a.PE0 = nullptr; a.PE1 = nullptr; a.ldk0 = 128; a.ldk1 = 128; a.has_sink = 1; a.scale = 0.125f;
      if (q < 512) {
        const int b = q >> 6, head = (q >> 3) & 7, qt = q & 7, kvh = head >> 2;
        const int row0 = NPR + b * 1024;
        a.Q = WSP(u16, O_QA) + (size_t)(row0 + qt * 128) * 512 + head * 64;
        a.K0 = WSP(u16, O_KA) + (size_t)row0 * 128 + kvh * 64;
        a.kb0 = qt * 128 - 128 < 0 ? 0 : qt * 128 - 128;
        a.ke0 = qt * 128 + 256 > 1024 ? 1024 : qt * 128 + 256;
        a.K1 = WSP(u16, O_KCA) + (size_t)((e * 8 + b) * 512) * 128 + kvh * 64;
        a.ke1 = 512;
        a.VT = WSP(u16, O_VTAL) + (size_t)(((e * 8 + b) * 2 + kvh) * 64) * 1536;
        a.ldvt = 1536; a.vtoff1 = 1024; a.banded = 1; a.qpos0 = qt * 128;
        a.sink = p.a_sink[e * 8 + head];
        a.O = WSP(u16, O_HM) + (size_t)(row0 + qt * 128) * 1024 + head * 64;
      } else {
        const int q2 = q - 512;
        const int b = q2 >> 4, head = (q2 >> 1) & 7, qt = q2 & 1, kvh = head >> 2;
        const int row0 = b * 256;
        a.Q = WSP(u16, O_QA) + (size_t)(row0 + qt * 128) * 512 + head * 64;
        a.K0 = WSP(u16, O_KA) + (size_t)row0 * 128 + kvh * 64;
        a.kb0 = 0; a.ke0 = 256;
        a.K1 = a.K0; a.ke1 = 0;
        a.VT = WSP(u16, O_VTAP) + (size_t)((b * 2 + kvh) * 64) * 256;
        a.ldvt = 256; a.vtoff1 = 0; a.banded = 0; a.qpos0 = 0;
        a.sink = p.a_sink[e * 8 + head];
        a.O = WSP(u16, O_HM) + (size_t)(row0 + qt * 128) * 1024 + head * 64;
      }
      attn_item<64>(smem, a);
    }
  }
}

DI void mixer_odd_phase(const P& p, char* smem, int o) {
  const int xg = bid_opaque() & 7;
  unsigned* ctr = (unsigned*)(p.ws + O_BAR) + 3600 + 64 * (2 + o) + xg;
  for (;;) {
    const int li = queue_next(smem, ctr);
    if (li >= 256) break;
    const int item = ((li >> 6) << 9) + ((li >> 6) < 2 ? xg * 64 + (li & 63) : xg * 64 + (li & 63));
    AttnArgs a;
    a.has_sink = 0; a.sink = 0.f; a.banded = 0; a.qpos0 = 0; a.kb0 = 0;
    const int grp = item >> 9, q = item & 511;
    const bool lat = grp < 2, isC = (grp & 1) == 0;
    int b, head, qt, row0, nk;
    if (lat) { b = q >> 6; head = (q >> 3) & 7; qt = q & 7; row0 = NPR + b * 1024; nk = 1024; }
    else { b = q >> 4; head = (q >> 1) & 7; qt = q & 1; row0 = b * 256; nk = 256; }
    a.ke0 = nk;
    a.ke1 = lat ? 512 : 0;
    a.ldvt = lat ? 1536 : 256;
    a.vtoff1 = 1024;
    if (isC) {
      a.Q = WSP(u16, O_QC) + (size_t)(row0 + qt * 128) * 768 + head * 96; a.ldq = 768;
      a.K0 = WSP(u16, O_KN) + (size_t)row0 * 512 + head * 64; a.ldk0 = 512;
      a.PE0 = WSP(u16, O_KPE) + (size_t)row0 * 32;
      a.K1 = WSP(u16, O_KN) + (size_t)(NROWS + b * 512) * 512 + head * 64; a.ldk1 = 512;
      a.PE1 = WSP(u16, O_PECTX) + (size_t)((o * 8 + b) * 512) * 32;
      a.VT = lat ? WSP(u16, O_VTCL) + (size_t)((b * 8 + head) * 64) * 1536
                 : WSP(u16, O_VTCP) + (size_t)((b * 8 + head) * 64) * 256;
      a.scale = 0.10206207261596575f;
      a.O = WSP(u16, O_HM) + (size_t)(row0 + qt * 128) * 1024 + head * 64;
      attn_item<96>(smem, a);
    } else {
      const int kvh = head >> 1;
      a.Q = WSP(u16, O_QD) + (size_t)(row0 + qt * 128) * 512 + head * 64; a.ldq = 512;
      a.K0 = WSP(u16, O_KD) + (size_t)row0 * 256 + kvh * 64; a.ldk0 = 256;
      a.PE0 = nullptr; a.PE1 = nullptr;
      a.K1 = WSP(u16, O_KCD) + (size_t)((o * 8 + b) * 512) * 256 + kvh * 64; a.ldk1 = 256;
      a.VT = lat ? WSP(u16, O_VTDL) + (size_t)(((o * 8 + b) * 4 + kvh) * 64) * 1536
                 : WSP(u16, O_VTDP) + (size_t)((b * 4 + kvh) * 64) * 256;
      a.scale = 0.125f;
      a.O = WSP(u16, O_HM) + (size_t)(row0 + qt * 128) * 1024 + 512 + head * 64;
      attn_item<64>(smem, a);
    }
  }
}


#define XB_TMO      128
#define XB_XCNT(j)  (256  + 64 * (j))
#define XB_XSUB(j)  (1280 + 64 * (j))
#define XB_XGEN(j)  (2304 + 64 * (j))
#define XB_TOP      3328
#define XB_TOPGEN   3392
#define XCD_BAR_WORDS 3456
#define XB_SPIN_CAP (1u << 20)
#define LAS __attribute__((address_space(3)))
DI unsigned xb_ld(unsigned* q) { return __hip_atomic_load(q, __ATOMIC_RELAXED, __HIP_MEMORY_SCOPE_AGENT); }
DI unsigned xb_add(unsigned* q, unsigned v) { return __hip_atomic_fetch_add(q, v, __ATOMIC_RELAXED, __HIP_MEMORY_SCOPE_AGENT); }
DI unsigned xb_xcc_id() { return (unsigned)__builtin_amdgcn_s_getreg((3 << 11) | 20) & 0xFu; }
#define XB_SPIN(cond, bar) do { unsigned _sp = 0; while (cond) { __builtin_amdgcn_s_sleep(1); \
    if ((++_sp & 255u) == 0u) { if (xb_ld(&(bar)[XB_TMO])) break; if (_sp > XB_SPIN_CAP) { atomicAdd(&(bar)[XB_TMO], 1u); break; } } } } while (0)
struct XcdBarrier { unsigned* bar; unsigned x; volatile LAS unsigned* st; };
DI XcdBarrier xcd_barrier_post(unsigned* bar, volatile LAS unsigned* st) {
  XcdBarrier b; b.bar = bar; b.x = xb_xcc_id(); b.st = st;
  if (threadIdx.x == 0) (void)xb_add(&bar[XB_XCNT(b.x)], 1u);
  return b;
}
DI void xcd_barrier_complete(unsigned* bar, unsigned x, unsigned& nloc, unsigned& nx) {
  const unsigned G = gridDim.x * gridDim.y * gridDim.z;
  unsigned sum, cnt, mine, sp = 0u;
  for (;;) {
    sum = 0u; cnt = 0u; mine = 0u;
#pragma unroll
    for (unsigned j = 0; j < 16; ++j) { const unsigned c = xb_ld(&bar[XB_XCNT(j)]); sum += c; cnt += (c > 0u) ? 1u : 0u; mine = (j == x) ? c : mine; }
    if (sum == G) break;
    __builtin_amdgcn_s_sleep(1);
    if ((++sp & 255u) == 0u) { if (xb_ld(&bar[XB_TMO])) break; if (sp > XB_SPIN_CAP) { atomicAdd(&bar[XB_TMO], 1u); break; } }
  }
  nloc = mine > 0u ? mine : 1u; nx = cnt > 0u ? cnt : 1u;
}
DI void xcd_barrier(const XcdBarrier& b) {
  asm volatile("s_waitcnt vmcnt(0)" ::: "memory");
  __syncthreads();
  if (threadIdx.x == 0) {
    unsigned* bar = b.bar;
    __builtin_amdgcn_s_waitcnt(0);
    unsigned nloc = b.st[0], nx = b.st[1];
    if (nloc == 0u) { xcd_barrier_complete(bar, b.x, nloc, nx); b.st[0] = nloc; b.st[1] = nx; }
    const unsigned old = xb_add(&bar[XB_XSUB(b.x)], 1u);
    const unsigned gen = old / nloc;
    if (old + 1u == (gen + 1u) * nloc) {
      __builtin_amdgcn_fence(__ATOMIC_RELEASE, "agent");
      asm volatile("s_waitcnt vmcnt(0)" ::: "memory");
      const unsigned og = xb_add(&bar[XB_TOP], 1u);
      const unsigned tg = og / nx;
      if (og + 1u == (tg + 1u) * nx) xb_add(&bar[XB_TOPGEN], 1u);
      else XB_SPIN(xb_ld(&bar[XB_TOPGEN]) == tg, bar);
      __builtin_amdgcn_fence(__ATOMIC_ACQUIRE, "agent");
      xb_add(&bar[XB_XGEN(b.x)], 1u);
      asm volatile("s_waitcnt vmcnt(0)" ::: "memory");
    } else {
      XB_SPIN(xb_ld(&bar[XB_XGEN(b.x)]) == gen, bar);
      __builtin_amdgcn_fence(__ATOMIC_ACQUIRE, "agent");
      asm volatile("s_waitcnt vmcnt(0)" ::: "memory");
    }
  }
  __syncthreads();
}

constexpr int N_PHASES = 2 + 2 * 17;

__global__ void __launch_bounds__(256, 2) mega(P p, int ph_lo, int ph_hi) {
  __shared__ __attribute__((aligned(16))) char smem[73728];
  cg::grid_group grid = cg::this_grid();
  __shared__ uint4 xb_words;
  if (threadIdx.x == 0) xb_words = make_uint4(0u, 0u, 0u, 0u);
  __syncthreads();
  XcdBarrier xb = xcd_barrier_post((unsigned*)(p.ws + O_BAR), (volatile LAS unsigned*)&xb_words);
  for (int ph = ph_lo; ph < ph_hi; ++ph) {
    if (ph == 0) prep_phase(p, smem);
    else if (ph == 1) h0_phase(p);
    else {
      const int q = ph - 2, pair = q / 17, rr = q % 17;
      int l, idx;
      if (rr < 8) {
        l = 2 * pair;
        const int map[8] = {0, 3, 4, 5, 6, 7, 8, 9};
        idx = rr == 0 ? 0 : rr + 2;
        (void)map;
      } else {
        l = 2 * pair + 1;
        const int r2 = rr - 8;
        idx = r2 < 4 ? r2 : r2 + 1;
      }
      const bool even = (l & 1) == 0;
#ifdef DUPMASK
      if ((DUPMASK >> idx) & 1) {
        if (idx == 0) gemm_phase(p, smem, even ? G_EVEN_IN : G_ODD_IN, l);
        else if (idx == 2) gemm_phase(p, smem, G_UPS, l);
        else if (idx == 3) { if (even) mixer_even_phase(p, smem, l >> 1); else mixer_odd_phase(p, smem, l >> 1); }
        else if (idx == 7) gemm_phase(p, smem, G_FFNUP, l);
        xcd_barrier(xb);
      }
#endif
      if (idx == 0) gemm_phase(p, smem, even ? G_EVEN_IN : G_ODD_IN, l);
      else if (idx == 1) post_odd_phase(p, l >> 1);
      else if (idx == 2) gemm_phase(p, smem, G_UPS, l);
      else if (idx == 3) { if (even) mixer_even_phase(p, smem, l >> 1); else mixer_odd_phase(p, smem, l >> 1); }
      else if (idx == 4) hfin_phase(p, l >> 1);
      else if (idx == 5) gemm_phase(p, smem, G_OUTP, l);
      else if (idx == 6) ln_phase(p, l, 0);
      else if (idx == 7) gemm_phase(p, smem, G_FFNUP, l);
      else if (idx == 8) gemm_phase(p, smem, G_FFNDN, l);
      else ln_phase(p, l, 1);
    }
    if (ph + 1 < ph_hi) { if (ph == ph_lo) grid.sync(); else xcd_barrier(xb); }
  }
}

extern "C" void kernel_launch(void* const* d_in, const int* in_sizes, int n_in, void* d_out, int out_size, void* d_ws,
                              size_t ws_size, hipStream_t stream) {
  static int grid_blocks = 0;
  if (!grid_blocks) {
    int dev = 0, cus = 0, per_cu = 0;
    hipGetDevice(&dev);
    hipDeviceGetAttribute(&cus, hipDeviceAttributeMultiprocessorCount, dev);
    hipOccupancyMaxActiveBlocksPerMultiprocessor(&per_cu, mega, 256, 0);
    if (per_cu > 2) per_cu = 2;
    if (per_cu < 1) per_cu = 1;
    grid_blocks = (cus * per_cu) & ~7;
  }
  P p{};
  const float** pp = (const float**)&p;
  for (int i = 0; i < 30; ++i) pp[i] = (const float*)d_in[i];
  p.out = (float*)d_out;
  p.ws = (char*)d_ws;
  hipMemsetAsync((char*)d_ws + O_BAR, 0, 16384, stream);
  hipMemsetAsync((char*)d_ws + O_MOD, 0, SZ_MOD, stream);
  int lo = 0, hi = N_PHASES;
  void* args[] = {&p, &lo, &hi};
  hipError_t e = hipLaunchCooperativeKernel((void*)mega, dim3(grid_blocks), dim3(256), args, 0, stream);
  if (e != hipSuccess) fprintf(stderr, "cooperative launch failed: %s (grid %d)\n", hipGetErrorString(e), grid_blocks);
}
```
